# Optimizing an MI355X kernel written in HIP

```python
import jax, jax.numpy as jnp
from jax import lax
import numpy as np

D_MODEL = 1024
BATCH = 16
SEQ = 256
DEPTH = 2
DEC_BATCH = 2
DEC_SEQ = 1024
PAST_LEN = 512

GRID_W = 64
N_MIXERS = 2
N_REC = (DEPTH + 1) // 2
N_ATT = DEPTH // 2
HEAD_DIM = 128
N_HEADS = D_MODEL // HEAD_DIM
N_KV_HEADS = 2
GROUP = N_HEADS // N_KV_HEADS
QKV_DIM = (N_HEADS + 2 * N_KV_HEADS) * HEAD_DIM
ROPE_THETA = 10000.0
Q_BLOCK = 128
D_RNN = D_MODEL
LRU_BLOCKS = 16
LRU_BLOCK_W = D_RNN // LRU_BLOCKS
CONV_W = 4
LRU_C = 8.0
D_FF = 2816
N_SUB = 3
EPS = 1e-6

kernel_name = "hybrid_rglru_gqa_prefix_diffusion_step"

F32 = jnp.float32


def rmsnorm(x, g):
    xf = x.astype(F32)
    y = xf * lax.rsqrt(jnp.mean(xf * xf, axis=-1, keepdims=True) + EPS)
    return (y * g.astype(F32)).astype(x.dtype)


def modulation(cvec, w, b):
    m = jax.nn.silu(cvec) @ w + b
    return m.reshape(cvec.shape[0], N_SUB, 3, D_MODEL)


def sub_in(x, g, m, sidx):
    shift, scale = m[:, sidx, 0], m[:, sidx, 1]
    return rmsnorm(x, g[sidx]) * (1 + scale[:, None, :]) + shift[:, None, :]


def sub_gate(m, sidx):
    return m[:, sidx, 2][:, None, :]


def swiglu(h, w_gu, w_down):
    gt, up = jnp.split(h @ w_gu, 2, axis=-1)
    return (jax.nn.silu(gt) * up) @ w_down


def centred_dwconv(x, w, b):
    T = x.shape[1]
    left = (CONV_W - 1) // 2
    right = CONV_W - 1 - left
    xp = jnp.pad(x, ((0, 0), (left, right), (0, 0)))
    out = b
    for k in range(CONV_W):
        out = out + xp[:, k:k + T] * w[k]
    return out


def linear_scan(a, u, h0, reverse):
    def step(h, au):
        a_t, u_t = au
        h = a_t * h + u_t
        return h, h
    h_last, hs = lax.scan(step, h0, (a.swapaxes(0, 1), u.swapaxes(0, 1)), reverse=reverse)
    return hs.swapaxes(0, 1), h_last


def rglru_block(xn, w_in, conv_w, conv_b, gate_w, gate_b, lam, w_out, h0):
    B, T, _ = xn.shape
    xb, yb = jnp.split(xn @ w_in, 2, axis=-1)
    xc = centred_dwconv(xb, conv_w, conv_b)
    xblk = xc.reshape(B, T, LRU_BLOCKS, LRU_BLOCK_W)
    gl = jnp.einsum('btnk,dgnkj->dgbtnj', xblk, gate_w).reshape(2, 2, B, T, D_RNN)
    gates = jax.nn.sigmoid(gl.astype(F32) + gate_b.astype(F32)[:, :, None, None, :])
    r, i = gates[:, 0], gates[:, 1]
    log_a = LRU_C * r * jax.nn.log_sigmoid(lam.astype(F32))[:, None, None, :]
    a = jnp.exp(log_a)
    u = jnp.sqrt(-jnp.expm1(2.0 * log_a)) * (i * xc.astype(F32)[None])
    h0f = h0.astype(F32)
    hf, hf_last = linear_scan(a[0], u[0], h0f[:, 0], False)
    hb, hb_last = linear_scan(a[1], u[1], h0f[:, 1], True)
    y = (hf + hb).astype(xn.dtype) * jax.nn.gelu(yb)
    return y @ w_out, jnp.stack([hf_last, hb_last], axis=1).astype(xn.dtype)


def axial_rope_angles(n_tok):
    rows = n_tok // GRID_W
    r_idx = jnp.broadcast_to(jnp.arange(rows)[:, None], (rows, GRID_W)).reshape(n_tok).astype(F32)
    c_idx = jnp.broadcast_to(jnp.arange(GRID_W)[None, :], (rows, GRID_W)).reshape(n_tok).astype(F32)
    n_freq = HEAD_DIM // 4
    inv = ROPE_THETA ** (-jnp.arange(n_freq, dtype=F32) / n_freq)
    ang = jnp.stack([r_idx[:, None] * inv, c_idx[:, None] * inv], axis=1)
    return jnp.cos(ang), jnp.sin(ang)


def apply_axial_rope(x, cos, sin):
    B, T, H, _ = x.shape
    xr = x.astype(F32).reshape(B, T, H, 2, 2, HEAD_DIM // 4)
    x0, x1 = xr[..., 0, :], xr[..., 1, :]
    c = cos[None, :, None]
    s = sin[None, :, None]
    out = jnp.stack([x0 * c - x1 * s, x0 * s + x1 * c], axis=-2)
    return out.reshape(B, T, H, HEAD_DIM).astype(x.dtype)


def qkv_heads(xn, w_qkv, q_g, k_g):
    B, T, _ = xn.shape
    q, k, v = jnp.split(xn @ w_qkv, [N_HEADS * HEAD_DIM, (N_HEADS + N_KV_HEADS) * HEAD_DIM], axis=-1)
    q = rmsnorm(q.reshape(B, T, N_HEADS, HEAD_DIM), q_g)
    k = rmsnorm(k.reshape(B, T, N_KV_HEADS, HEAD_DIM), k_g)
    v = v.reshape(B, T, N_KV_HEADS, HEAD_DIM)
    return q, k, v


def block_attention(q, k, v):
    B, S = q.shape[0], q.shape[1]
    nb = S // Q_BLOCK
    qb = q.reshape(B, nb, Q_BLOCK, N_KV_HEADS, GROUP, HEAD_DIM).transpose(1, 0, 2, 3, 4, 5)
    scale = HEAD_DIM ** -0.5

    def one_block(qblk):
        s = jnp.einsum('bqkgd,btkd->bkgqt', qblk, k).astype(F32) * scale
        p = jax.nn.softmax(s, axis=-1).astype(v.dtype)
        return jnp.einsum('bkgqt,btkd->bqkgd', p, v)

    o = lax.map(one_block, qb)
    return o.transpose(1, 0, 2, 3, 4, 5).reshape(B, S, N_HEADS * HEAD_DIM)


def setup_inputs(seed: int = 0) -> dict:
    key = jax.random.key(seed)
    ks = jax.random.split(key, 26)

    def nrm(k, shape, s):
        return jax.random.normal(k, shape, F32) * s

    u = jax.random.uniform(ks[15], (N_REC, 2, D_RNN), F32, minval=0.9, maxval=0.999)
    a0 = u ** (1.0 / LRU_C)
    lam = jnp.log(a0) - jnp.log1p(-a0)
    return {
        "x_prompt": nrm(ks[0], (BATCH, SEQ, D_MODEL), 1.0),
        "x_sample": nrm(ks[1], (DEC_BATCH, DEC_SEQ, D_MODEL), 1.0),
        "c": nrm(ks[2], (DEC_BATCH, D_MODEL), 1.0),
        "state_lru": nrm(ks[3], (DEC_BATCH, N_REC, 2, D_RNN), 0.5),
        "cache_k": nrm(ks[4], (DEC_BATCH, N_ATT, PAST_LEN, N_KV_HEADS, HEAD_DIM), 1.0),
        "cache_v": nrm(ks[5], (DEC_BATCH, N_ATT, PAST_LEN, N_KV_HEADS, HEAD_DIM), 1.0),
        "c_ctx": nrm(ks[6], (D_MODEL,), 1.0),
        "mod_w": nrm(ks[7], (DEPTH, D_MODEL, N_SUB * 3 * D_MODEL), 0.5 * D_MODEL ** -0.5),
        "mod_b": nrm(ks[8], (DEPTH, N_SUB * 3 * D_MODEL), 0.02),
        "norm_g": 1.0 + nrm(ks[9], (DEPTH, N_SUB, D_MODEL), 0.02),
        "ffn_w_gu": nrm(ks[10], (DEPTH, 2, D_MODEL, 2 * D_FF), D_MODEL ** -0.5),
        "ffn_w_down": nrm(ks[11], (DEPTH, 2, D_FF, D_MODEL), D_FF ** -0.5),
        "lru_w_in": nrm(ks[12], (N_REC, D_MODEL, 2 * D_RNN), D_MODEL ** -0.5),
        "lru_conv_w": nrm(ks[13], (N_REC, CONV_W, D_RNN), CONV_W ** -0.5),
        "lru_conv_b": nrm(ks[14], (N_REC, D_RNN), 0.01),
        "lru_gate_w": nrm(ks[16], (N_REC, 2, 2, LRU_BLOCKS, LRU_BLOCK_W, LRU_BLOCK_W), LRU_BLOCK_W ** -0.5),
        "lru_gate_b": nrm(ks[17], (N_REC, 2, 2, D_RNN), 0.01),
        "lru_lambda": lam,
        "lru_w_out": nrm(ks[18], (N_REC, D_RNN, D_MODEL), D_RNN ** -0.5),
        "att_w_qkv": nrm(ks[19], (N_ATT, D_MODEL, QKV_DIM), D_MODEL ** -0.5),
        "att_q_g": 1.0 + nrm(ks[20], (N_ATT, HEAD_DIM), 0.02),
        "att_k_g": 1.0 + nrm(ks[21], (N_ATT, HEAD_DIM), 0.02),
        "att_w_o": nrm(ks[22], (N_ATT, N_HEADS * HEAD_DIM, D_MODEL), (N_HEADS * HEAD_DIM) ** -0.5),
        "final_g": 1.0 + nrm(ks[23], (D_MODEL,), 0.02),
    }


def reference(x_prompt, x_sample, c, state_lru, cache_k, cache_v, c_ctx, mod_w, mod_b, norm_g,
              ffn_w_gu, ffn_w_down, lru_w_in, lru_conv_w, lru_conv_b, lru_gate_w, lru_gate_b,
              lru_lambda, lru_w_out, att_w_qkv, att_q_g, att_k_g, att_w_o, final_g):
    xp, xs = x_prompt, x_sample
    cos, sin = axial_rope_angles(xs.shape[1])
    new_states, new_k, new_v = [], [], []
    for layer in range(DEPTH):
        j = layer // N_MIXERS
        g = norm_g[layer]
        mp = modulation(c_ctx[None], mod_w[layer], mod_b[layer])
        ms = modulation(c, mod_w[layer], mod_b[layer])

        xp = xp + 0.5 * sub_gate(mp, 0) * swiglu(sub_in(xp, g, mp, 0), ffn_w_gu[layer, 0], ffn_w_down[layer, 0])
        xs = xs + 0.5 * sub_gate(ms, 0) * swiglu(sub_in(xs, g, ms, 0), ffn_w_gu[layer, 0], ffn_w_down[layer, 0])

        hp = sub_in(xp, g, mp, 1)
        hs = sub_in(xs, g, ms, 1)
        if layer % N_MIXERS == 0:
            lru_p = (lru_w_in[j], lru_conv_w[j], lru_conv_b[j], lru_gate_w[j], lru_gate_b[j],
                     lru_lambda[j], lru_w_out[j])
            h0 = jnp.zeros((xp.shape[0], 2, D_RNN), xp.dtype)
            op, st = rglru_block(hp, *lru_p, h0)
            new_states.append(st)
            os_, _ = rglru_block(hs, *lru_p, state_lru[:, j])
        else:
            qp, kp, vp = qkv_heads(hp, att_w_qkv[j], att_q_g[j], att_k_g[j])
            new_k.append(kp)
            new_v.append(vp)
            op = block_attention(qp, kp, vp) @ att_w_o[j]
            qs, ks_, vs = qkv_heads(hs, att_w_qkv[j], att_q_g[j], att_k_g[j])
            qs = apply_axial_rope(qs, cos, sin)
            ks_ = apply_axial_rope(ks_, cos, sin)
            k_all = jnp.concatenate([cache_k[:, j].astype(ks_.dtype), ks_], axis=1)
            v_all = jnp.concatenate([cache_v[:, j].astype(vs.dtype), vs], axis=1)
            os_ = block_attention(qs, k_all, v_all) @ att_w_o[j]
        xp = xp + sub_gate(mp, 1) * op
        xs = xs + sub_gate(ms, 1) * os_

        xp = xp + 0.5 * sub_gate(mp, 2) * swiglu(sub_in(xp, g, mp, 2), ffn_w_gu[layer, 1], ffn_w_down[layer, 1])
        xs = xs + 0.5 * sub_gate(ms, 2) * swiglu(sub_in(xs, g, ms, 2), ffn_w_gu[layer, 1], ffn_w_down[layer, 1])

    y_prompt = rmsnorm(xp, final_g)
    y_sample = rmsnorm(xs, final_g)
    new_state_lru = jnp.stack(new_states, axis=1)
    new_cache_k = jnp.stack(new_k, axis=1)
    new_cache_v = jnp.stack(new_v, axis=1)
    return (y_prompt, y_sample, new_state_lru, new_cache_k, new_cache_v)
```

```cpp
#include <hip/hip_runtime.h>
#include <hip/hip_bf16.h>
#include <cstdio>
#include <cstdint>

#ifndef MK_PER_PHASE
#define MK_PER_PHASE 0
#endif

namespace pg8 {
#define PG8_LAS __attribute__((address_space(3)))
typedef unsigned short bf16_t;
typedef short bf16x8 __attribute__((ext_vector_type(8)));
typedef float f32x4 __attribute__((ext_vector_type(4)));
typedef unsigned u32x4 __attribute__((ext_vector_type(4)));
constexpr int BM = 256, BK = 64, HALF = 128, HTB = HALF * BK * 2  , STAGE_BYTES = 8 * HTB, NXCD = 8, WGM = 8;

__host__ __device__ __forceinline__ int lds_byte(int r, int c) { const int st = (r >> 4) * 2 + (c >> 5), rr = r & 15, cc = c & 31, ob = rr * 64 + cc * 2; return st * 1024 + (ob ^ (((ob >> 9) & 1) << 5)); }
__host__ __device__ __forceinline__ void stage_rc(int b, int& R, int& C) { const int st = b / 1024, sb = b % 1024, swz = sb ^ (((sb >> 9) & 1) << 5); R = (st >> 1) * 16 + swz / 64; C = (st & 1) * 32 + (swz % 64) / 2; }
__host__ __device__ __forceinline__ int perm32(int rho) { const int n = rho >> 4, i = rho & 15; return 8 * (i >> 2) + 4 * n + (i & 3); }

struct Unit { int pm, pn, kz; };
struct Gemm { const bf16_t* A; const bf16_t* Bt; int M, N, K, ld, nz; };

struct StaticOrder {
    int nM, nN, nmn, nwg, G, c;
    __host__ __device__ void init(int M, int N, int nz, int G_, int c_) { nM = M / BM; nN = N / BM; nmn = nM * nN; nwg = nmn * nz; G = G_; c = c_; }
    __host__ __device__ bool next(int i, Unit& u) const {
        const long L = (long)i * G + c; if (L >= nwg) return false;
        u.kz = (int)(L / nmn);
        int wgid = (int)(L % nmn); { const int q = nmn / NXCD, r = nmn % NXCD, xcd = wgid % NXCD, off = wgid / NXCD; wgid = (xcd < r ? xcd * (q + 1) : r * (q + 1) + (xcd - r) * q) + off; }
        const int nig = WGM * nN, gid = wgid / nig, fm = gid * WGM, gsz = (nM - fm) < WGM ? (nM - fm) : WGM;
        u.pm = fm + ((wgid % nig) % gsz); u.pn = (wgid % nig) / gsz; return true;
    }
    __device__ __forceinline__ void a_ready(const Unit&) const {}
    __device__ __forceinline__ void done(const Unit&) const {}
};

__device__ __forceinline__ unsigned cvt_pk_bf16(float lo, float hi) { unsigned r; asm volatile("v_cvt_pk_bf16_f32 %0, %1, %2" : "=v"(r) : "v"(lo), "v"(hi)); return r; }

struct EpiStoreBf16 {
    static constexpr bool PERM = true, AFTER_DRAIN = false;
    bf16_t* O; int ldc;
    __device__ __forceinline__ void operator()(const f32x4 (&acc)[2][2][4][2], const Unit& u, int wr, int wc, int fr, int fq) const {
        const int row0 = u.pm * BM + wr * 64 + fr, col0 = u.pn * BM + wc * 32 + 8 * fq;
#pragma unroll
        for (int ai = 0; ai < 2; ++ai)
#pragma unroll
            for (int m = 0; m < 4; ++m) { bf16_t* rowp = O + (size_t)(row0 + ai * HALF + m * 16) * ldc + col0;
#pragma unroll
                for (int bj = 0; bj < 2; ++bj) { const f32x4 v0 = acc[ai][bj][m][0], v1 = acc[ai][bj][m][1];
                    u32x4 w; w.x = cvt_pk_bf16(v0[0], v0[1]); w.y = cvt_pk_bf16(v0[2], v0[3]); w.z = cvt_pk_bf16(v1[0], v1[1]); w.w = cvt_pk_bf16(v1[2], v1[3]);
                    *(u32x4*)(rowp + bj * HALF) = w; } }
    }
};
__device__ __forceinline__ float silu_mul(float g, float u) { return g * u * __builtin_amdgcn_rcpf(1.0f + __builtin_amdgcn_exp2f(-1.4426950408889634f * g)); }
struct EpiSwiglu {
    static constexpr bool PERM = true, AFTER_DRAIN = false;
    bf16_t* O; int ldc;
    __device__ __forceinline__ void operator()(const f32x4 (&acc)[2][2][4][2], const Unit& u, int wr, int wc, int fr, int fq) const {
        const int row0 = u.pm * BM + wr * 64 + fr, col0 = u.pn * HALF + wc * 32 + 8 * fq;
#pragma unroll
        for (int ai = 0; ai < 2; ++ai)
#pragma unroll
            for (int m = 0; m < 4; ++m) { bf16_t* rowp = O + (size_t)(row0 + ai * HALF + m * 16) * ldc + col0;
                const f32x4 g0 = acc[ai][0][m][0], g1 = acc[ai][0][m][1], u0 = acc[ai][1][m][0], u1 = acc[ai][1][m][1];
                u32x4 w; w.x = cvt_pk_bf16(silu_mul(g0[0], u0[0]), silu_mul(g0[1], u0[1])); w.y = cvt_pk_bf16(silu_mul(g0[2], u0[2]), silu_mul(g0[3], u0[3]));
                w.z = cvt_pk_bf16(silu_mul(g1[0], u1[0]), silu_mul(g1[1], u1[1])); w.w = cvt_pk_bf16(silu_mul(g1[2], u1[2]), silu_mul(g1[3], u1[3]));
                *(u32x4*)rowp = w; }
    }
};
struct EpiF32Slab {
    static constexpr bool PERM = false, AFTER_DRAIN = false;
    float* C; size_t slab; int ldc;
    __device__ __forceinline__ void operator()(const f32x4 (&acc)[2][2][4][2], const Unit& u, int wr, int wc, int fr, int fq) const {
        const int row0 = u.pm * BM + wr * 64 + fr, col0 = u.pn * BM + wc * 32 + 4 * fq; float* Cz = C + (size_t)u.kz * slab;
#pragma unroll
        for (int ai = 0; ai < 2; ++ai)
#pragma unroll
            for (int m = 0; m < 4; ++m) { float* rowp = Cz + (size_t)(row0 + ai * HALF + m * 16) * ldc + col0;
#pragma unroll
                for (int bj = 0; bj < 2; ++bj)
#pragma unroll
                    for (int n = 0; n < 2; ++n) *(f32x4*)(rowp + bj * HALF + n * 16) = acc[ai][bj][m][n]; }
    }
};

template <class Epi, class Sched, bool ALIGN_EPI = false, bool SP2 = false>
__device__ __forceinline__ void gemm_phase(PG8_LAS unsigned char* lds, const Gemm g, const Sched& S, const Epi& E) {
    const int tid = threadIdx.x, wid = __builtin_amdgcn_readfirstlane(tid >> 6), lane = tid & 63, wr = wid >> 2, wc = wid & 3, fr = lane & 15, fq = lane >> 4;
    const int K = g.K, LD = g.ld, nt = K / BK;
    unsigned voffA[2], voffB[2];
#pragma unroll
    for (int i = 0; i < 2; ++i) { int R, C; stage_rc(tid * 16 + i * 8192, R, C); const int Rb = Epi::PERM ? ((R & ~31) + perm32(R & 31)) : R;
        voffA[i] = (unsigned)(R * LD + C) * 2u; voffB[i] = (unsigned)(Rb * LD + C) * 2u; }
    const size_t kstep = (size_t)(BK * 2);
    const size_t hstep = (size_t)HALF * LD * 2;
    const size_t tstep = 2 * hstep;
    const unsigned ldsw = (unsigned)wid * 1024u;
    const int aoff = lds_byte(wr * 64 + fr, fq * 8), boff = lds_byte(wc * 32 + fr, fq * 8);
#define PG8_SA(b, h) (((b) * 2 + (h)) * HTB)
#define PG8_SB(b, h) ((4 + (b) * 2 + (h)) * HTB)
#define PG8_STAGE(bufoff, gbase, voff) do { _Pragma("unroll") for (int _i = 0; _i < 2; ++_i) \
        __builtin_amdgcn_global_load_lds((const unsigned*)((const char*)(gbase) + (voff)[_i]), (PG8_LAS unsigned*)(lds + (bufoff) + ldsw + _i * 8192), 16, 0, 0); } while (0)
#define PG8_LDA(dst, b, h) do { _Pragma("unroll") for (int m = 0; m < 4; ++m) _Pragma("unroll") for (int k = 0; k < 2; ++k) dst[m][k] = *(const PG8_LAS bf16x8*)(lds + PG8_SA(b, h) + aoff + m * 2048 + k * 1024); } while (0)
#define PG8_LDB(dst, b, h) do { _Pragma("unroll") for (int n = 0; n < 2; ++n) _Pragma("unroll") for (int k = 0; k < 2; ++k) dst[n][k] = *(const PG8_LAS bf16x8*)(lds + PG8_SB(b, h) + boff + n * 2048 + k * 1024); } while (0)
#define PG8_MMA(ai, bj, At, Bt) do { __builtin_amdgcn_s_setprio(1); _Pragma("unroll") for (int m = 0; m < 4; ++m) _Pragma("unroll") for (int n = 0; n < 2; ++n) _Pragma("unroll") for (int k = 0; k < 2; ++k) \
        acc[ai][bj][m][n] = __builtin_amdgcn_mfma_f32_16x16x32_bf16(Bt[n][k], At[m][k], acc[ai][bj][m][n], 0, 0, 0); __builtin_amdgcn_s_setprio(0); } while (0)
#define PG8_WAIT_V(n) asm volatile("s_waitcnt vmcnt(" #n ")" ::: "memory")
#define PG8_WAIT_L(n) asm volatile("s_waitcnt lgkmcnt(" #n ")" ::: "memory")
#define PG8_BAR __builtin_amdgcn_s_barrier()
#define PG8_SCHED __builtin_amdgcn_sched_barrier(0)
    Unit cur, nxt; int ui = 0;
    if (!S.next(0, cur)) return;
    f32x4 acc[2][2][4][2];
#pragma unroll
    for (int a = 0; a < 2; ++a)
#pragma unroll
        for (int b = 0; b < 2; ++b)
#pragma unroll
            for (int m = 0; m < 4; ++m)
#pragma unroll
                for (int n = 0; n < 2; ++n) acc[a][b][m][n] = (f32x4){0.f, 0.f, 0.f, 0.f};
    bf16x8 At[4][2], B0[2][2], B1[2][2];
    const char* cA = (const char*)g.A + (size_t)cur.pm * tstep + (size_t)cur.kz * K * 2; const char* cB = (const char*)g.Bt + (size_t)cur.pn * tstep + (size_t)cur.kz * K * 2;
    S.a_ready(cur);
    if constexpr (SP2) {
        PG8_STAGE(PG8_SB(0, 0), cB, voffB); PG8_STAGE(PG8_SB(0, 1), cB + hstep, voffB); PG8_STAGE(PG8_SA(0, 0), cA, voffA); PG8_STAGE(PG8_SA(0, 1), cA + hstep, voffA);
        if (wr == 1) PG8_BAR;
        PG8_WAIT_V(2); PG8_BAR;
        PG8_STAGE(PG8_SB(1, 0), cB + kstep, voffB); PG8_STAGE(PG8_SA(1, 0), cA + kstep, voffA); PG8_STAGE(PG8_SB(1, 1), cB + hstep + kstep, voffB);
        PG8_WAIT_V(6); PG8_BAR;
    } else {
        PG8_STAGE(PG8_SB(0, 0), cB, voffB); PG8_STAGE(PG8_SA(0, 0), cA, voffA); PG8_STAGE(PG8_SB(0, 1), cB + hstep, voffB); PG8_STAGE(PG8_SA(0, 1), cA + hstep, voffA);
        if (wr == 1) PG8_BAR;
        PG8_WAIT_V(4); PG8_BAR;
        PG8_STAGE(PG8_SB(1, 0), cB + kstep, voffB); PG8_STAGE(PG8_SA(1, 0), cA + kstep, voffA); PG8_STAGE(PG8_SB(1, 1), cB + hstep + kstep, voffB);
        PG8_WAIT_V(6); PG8_BAR;
    }
    for (;;) {
        const bool has_next = S.next(ui + 1, nxt);
        const char* nA = has_next ? (const char*)g.A + (size_t)nxt.pm * tstep + (size_t)nxt.kz * K * 2 : cA; const char* nB = has_next ? (const char*)g.Bt + (size_t)nxt.pn * tstep + (size_t)nxt.kz * K * 2 : cB;
        for (int t = 0; t < nt; t += 2) {
            const bool last = (t == nt - 2);
            const char* a1 = cA + (size_t)(t + 1) * kstep;
            const char* a2 = last ? nA : cA + (size_t)(t + 2) * kstep; const char* b2 = last ? nB : cB + (size_t)(t + 2) * kstep;
            const char* a3 = a2 + kstep; const char* b3 = b2 + kstep;
            if (last && has_next) S.a_ready(nxt);
            if constexpr (SP2) {
            PG8_LDB(B0, 0, 0); PG8_LDB(B1, 0, 1); PG8_SCHED; PG8_LDA(At, 0, 0); PG8_STAGE(PG8_SA(1, 1), a1 + hstep, voffA);
            PG8_WAIT_V(8); PG8_WAIT_L(0); PG8_BAR; PG8_MMA(0, 0, At, B0); PG8_MMA(0, 1, At, B1); PG8_BAR; PG8_SCHED;
            PG8_LDA(At, 0, 1); PG8_STAGE(PG8_SB(0, 0), b2, voffB); PG8_STAGE(PG8_SB(0, 1), b2 + hstep, voffB); PG8_STAGE(PG8_SA(0, 0), a2, voffA);
            PG8_WAIT_V(8); PG8_WAIT_L(0); PG8_BAR; PG8_MMA(1, 0, At, B0); PG8_MMA(1, 1, At, B1); PG8_BAR; PG8_SCHED;
            PG8_LDB(B0, 1, 0); PG8_LDB(B1, 1, 1); PG8_SCHED; PG8_LDA(At, 1, 0); PG8_STAGE(PG8_SA(0, 1), a2 + hstep, voffA);
            PG8_WAIT_V(8); PG8_WAIT_L(0); PG8_BAR; PG8_MMA(0, 0, At, B0); PG8_MMA(0, 1, At, B1); PG8_BAR; PG8_SCHED;
            PG8_LDA(At, 1, 1); PG8_STAGE(PG8_SB(1, 0), b3, voffB); PG8_STAGE(PG8_SB(1, 1), b3 + hstep, voffB); PG8_STAGE(PG8_SA(1, 0), a3, voffA);
            PG8_WAIT_V(8); PG8_WAIT_L(0); PG8_BAR; PG8_MMA(1, 0, At, B0); PG8_MMA(1, 1, At, B1); PG8_BAR; PG8_SCHED;
            } else {
            PG8_LDB(B0, 0, 0); PG8_SCHED; PG8_LDA(At, 0, 0); PG8_STAGE(PG8_SA(1, 1), a1 + hstep, voffA);
            PG8_WAIT_L(8); PG8_BAR; PG8_WAIT_L(0); PG8_MMA(0, 0, At, B0); PG8_BAR; PG8_SCHED;
            PG8_LDB(B1, 0, 1); PG8_STAGE(PG8_SB(0, 0), b2, voffB);
            PG8_BAR; PG8_WAIT_L(0); PG8_MMA(0, 1, At, B1); PG8_BAR;
            PG8_LDA(At, 0, 1); PG8_STAGE(PG8_SA(0, 0), a2, voffA);
            PG8_BAR; PG8_WAIT_L(0); PG8_MMA(1, 0, At, B0); PG8_BAR; PG8_SCHED;
            PG8_STAGE(PG8_SB(0, 1), b2 + hstep, voffB);
            PG8_WAIT_V(6); PG8_BAR; PG8_MMA(1, 1, At, B1); PG8_BAR;
            PG8_LDB(B0, 1, 0); PG8_SCHED; PG8_LDA(At, 1, 0); PG8_STAGE(PG8_SA(0, 1), a2 + hstep, voffA);
            PG8_WAIT_L(8); PG8_BAR; PG8_WAIT_L(0); PG8_MMA(0, 0, At, B0); PG8_BAR; PG8_SCHED;
            PG8_LDB(B1, 1, 1); PG8_STAGE(PG8_SB(1, 0), b3, voffB);
            PG8_BAR; PG8_WAIT_L(0); PG8_MMA(0, 1, At, B1); PG8_BAR;
            PG8_LDA(At, 1, 1); PG8_STAGE(PG8_SA(1, 0), a3, voffA);
            PG8_BAR; PG8_WAIT_L(0); PG8_MMA(1, 0, At, B0); PG8_BAR; PG8_SCHED;
            PG8_STAGE(PG8_SB(1, 1), b3 + hstep, voffB);
            PG8_WAIT_V(6); PG8_BAR; PG8_MMA(1, 1, At, B1); PG8_BAR;
            }
        }
        if constexpr (ALIGN_EPI) { if (wr == 0) PG8_BAR; }
        if constexpr (!Epi::AFTER_DRAIN) { E(acc, cur, wr, wc, fr, fq); S.done(cur); }
        if (!has_next) break;
#pragma unroll
        for (int a = 0; a < 2; ++a)
#pragma unroll
            for (int b = 0; b < 2; ++b)
#pragma unroll
                for (int m = 0; m < 4; ++m)
#pragma unroll
                    for (int n = 0; n < 2; ++n) acc[a][b][m][n] = (f32x4){0.f, 0.f, 0.f, 0.f};
        cur = nxt; cA = nA; cB = nB; ++ui;
        if constexpr (ALIGN_EPI) { if (wr == 1) PG8_BAR; }
    }
    PG8_WAIT_V(0);
    if constexpr (!ALIGN_EPI) { if (wr == 0) PG8_BAR; }
    PG8_BAR;
    if constexpr (Epi::AFTER_DRAIN) { E.fused(acc, cur, wr, wc, fr, fq, lds, wid, lane); S.done(cur); }
#undef PG8_SA
#undef PG8_SB
#undef PG8_STAGE
#undef PG8_LDA
#undef PG8_LDB
#undef PG8_MMA
#undef PG8_WAIT_V
#undef PG8_WAIT_L
#undef PG8_BAR
#undef PG8_SCHED
}
}
namespace att {
using bf16 = __hip_bfloat16;
constexpr int   D = 128, NW = 8, QBLK = 32, KVBLK = 64;
constexpr float SCALE = 0.088388347648318440f;
constexpr float THR = 8.f;
constexpr int SDEPTH = 2;
constexpr int LDQ = 1024, LDK = 256, LDO = 1024;
constexpr size_t SHM_V = KVBLK * D * 2, SHM_K = KVBLK * D * 2, SHM_ATTN = 2 * SHM_V + 2 * SHM_K + NW * 64 * 4;
using bf16x8 = __attribute__((ext_vector_type(8))) short;
using s16x4  = __attribute__((ext_vector_type(4))) short;
using f32x16 = __attribute__((ext_vector_type(16))) float;
using u32x4  = __attribute__((ext_vector_type(4))) unsigned;
#define KSWZ(row, colB) ((row) * 256 + ((colB) ^ (((row) & 7) << 4)))
#define SBAR() __builtin_amdgcn_sched_barrier(0)
__device__ __forceinline__ int crow(int r, int hi) { return (r & 3) + 8 * (r >> 2) + 4 * hi; }
__device__ __forceinline__ unsigned cvtpk(float lo, float hi) {
  unsigned r; asm volatile("v_cvt_pk_bf16_f32 %0, %1, %2" : "=v"(r) : "v"(lo), "v"(hi)); return r;
}
__device__ __forceinline__ bf16x8 ld8(const bf16* p) { return *reinterpret_cast<const bf16x8*>(p); }

__device__ __forceinline__ void partialSM(f32x16& p0, f32x16& p1, float& m_reg, float& mn, float& alpha) {
  constexpr float C = SCALE * 1.4426950408889634f;
  float pmax = p0[0]; for (int r = 1; r < 16; ++r) pmax = fmaxf(pmax, p0[r]); for (int r = 0; r < 16; ++r) pmax = fmaxf(pmax, p1[r]);
  { auto rr = __builtin_amdgcn_permlane32_swap(__float_as_uint(pmax), __float_as_uint(pmax), false, false);
    pmax = fmaxf(__uint_as_float(rr[0]), __uint_as_float(rr[1])); }
  if (__builtin_expect(__all(pmax - m_reg <= THR / SCALE), 1)) { mn = m_reg; alpha = 1.f; }
  else { mn = fmaxf(m_reg, pmax); alpha = __builtin_amdgcn_exp2f((m_reg - mn) * C); m_reg = mn; }
  float mnC = -mn * C;
  for (int r = 0; r < 16; ++r) p0[r] = fmaf(p0[r], C, mnC); for (int r = 0; r < 16; ++r) p1[r] = fmaf(p1[r], C, mnC);
  for (int r = 0; r < 16; ++r) p0[r] = __builtin_amdgcn_exp2f(p0[r]);
}
__device__ __forceinline__ void finishSM(f32x16& p0, f32x16& p1, float alpha, float& l_reg, bf16x8& pa0, bf16x8& pa1, bf16x8& pa2, bf16x8& pa3) {
  for (int r = 0; r < 16; ++r) p1[r] = __builtin_amdgcn_exp2f(p1[r]);
  float ps = 0; for (int r = 0; r < 16; ++r) ps += p0[r]; for (int r = 0; r < 16; ++r) ps += p1[r];
  { auto rr = __builtin_amdgcn_permlane32_swap(__float_as_uint(ps), __float_as_uint(ps), false, false);
    ps = __uint_as_float(rr[0]) + __uint_as_float(rr[1]); }
  l_reg = l_reg * alpha + ps;
#define PK4(P, BASE, OUT) do { unsigned a0 = cvtpk(P[BASE + 0], P[BASE + 1]), a1 = cvtpk(P[BASE + 2], P[BASE + 3]);   \
    unsigned b0 = cvtpk(P[BASE + 4], P[BASE + 5]), b1 = cvtpk(P[BASE + 6], P[BASE + 7]);                              \
    auto r0 = __builtin_amdgcn_permlane32_swap(a0, b0, false, false); auto r1 = __builtin_amdgcn_permlane32_swap(a1, b1, false, false); \
    u32x4 w = {r0[0], r1[0], r0[1], r1[1]}; OUT = *reinterpret_cast<bf16x8*>(&w); } while (0)
  PK4(p0, 0, pa0); PK4(p0, 8, pa1); PK4(p1, 0, pa2); PK4(p1, 8, pa3);
#undef PK4
}
__device__ __forceinline__ void qkt(f32x16& p0, f32x16& p1, const bf16* Ks, const bf16x8* qr, int r32, int hi) {
  p0 = f32x16{}; p1 = f32x16{};
  for (int d0 = 0; d0 < 8; ++d0) { int cb = (d0 * 16 + hi * 8) * 2;
    bf16x8 b0 = *reinterpret_cast<const bf16x8*>((const char*)Ks + KSWZ(r32, cb));
    bf16x8 b1 = *reinterpret_cast<const bf16x8*>((const char*)Ks + KSWZ(32 + r32, cb));
    p0 = __builtin_amdgcn_mfma_f32_32x32x16_bf16(b0, qr[d0], p0, 0, 0, 0);
    p1 = __builtin_amdgcn_mfma_f32_32x32x16_bf16(b1, qr[d0], p1, 0, 0, 0); }
}
__device__ __forceinline__ int v_st(int k, int c) { const int kk = (k & ~0xC) | ((k & 4) << 1) | ((k & 8) >> 1); return ((kk >> 3) * 4 + (c >> 5)) * 512 + ((kk & 7) * 32 + (c & 31)) * 2; }
__device__ __forceinline__ int v_rd_base(int lane) { return ((lane & 3) << 3) | (((lane >> 2) & 3) << 6) | (((lane >> 4) & 1) << 5) | (((lane >> 5) & 1) << 8); }
constexpr int v_rd_off(int d0, int ks, int half) { return d0 * 512 + ks * 4096 + half * 2048; }
template <int OFF> __device__ __forceinline__ s16x4 tr_read(int vb) {
  s16x4 r; asm volatile("ds_read_b64_tr_b16 %0, %1 offset:%2" : "=&v"(r) : "v"(vb), "i"(OFF) : "memory"); return r;
}
template <int D0> __device__ __forceinline__ void pv_one(f32x16& od, int vb, bf16x8 pa0, bf16x8 pa1, bf16x8 pa2, bf16x8 pa3) {
  const s16x4 l0 = tr_read<v_rd_off(D0, 0, 0)>(vb), h0 = tr_read<v_rd_off(D0, 0, 1)>(vb), l1 = tr_read<v_rd_off(D0, 1, 0)>(vb), h1 = tr_read<v_rd_off(D0, 1, 1)>(vb);
  const s16x4 l2 = tr_read<v_rd_off(D0, 2, 0)>(vb), h2 = tr_read<v_rd_off(D0, 2, 1)>(vb), l3 = tr_read<v_rd_off(D0, 3, 0)>(vb), h3 = tr_read<v_rd_off(D0, 3, 1)>(vb);
  asm volatile("s_waitcnt lgkmcnt(0)" ::: "memory"); SBAR();
#define PK(L, H) (bf16x8){L[0], L[1], L[2], L[3], H[0], H[1], H[2], H[3]}
  od = __builtin_amdgcn_mfma_f32_32x32x16_bf16(pa0, PK(l0, h0), od, 0, 0, 0);
  od = __builtin_amdgcn_mfma_f32_32x32x16_bf16(pa1, PK(l1, h1), od, 0, 0, 0);
  od = __builtin_amdgcn_mfma_f32_32x32x16_bf16(pa2, PK(l2, h2), od, 0, 0, 0);
  od = __builtin_amdgcn_mfma_f32_32x32x16_bf16(pa3, PK(l3, h3), od, 0, 0, 0);
#undef PK
}
__device__ __forceinline__ void pv_d0(f32x16* o, int vb, bf16x8 pa0, bf16x8 pa1, bf16x8 pa2, bf16x8 pa3) {
  pv_one<0>(o[0], vb, pa0, pa1, pa2, pa3); pv_one<1>(o[1], vb, pa0, pa1, pa2, pa3); pv_one<2>(o[2], vb, pa0, pa1, pa2, pa3); pv_one<3>(o[3], vb, pa0, pa1, pa2, pa3);
}
__device__ __forceinline__ void attn_dense_body(const bf16* __restrict__ Qb, const bf16* __restrict__ Kh, const bf16* __restrict__ Vh,
                                                bf16* __restrict__ Ob, int seq, char* lds) {
  const int tid = threadIdx.x, wid = tid >> 6, lane = tid & 63, r32 = lane & 31, hi = lane >> 5;
  bf16* V_lds = (bf16*)lds; bf16* K_lds = (bf16*)(lds + 2 * SHM_V);
  float* ws = (float*)(lds + 2 * SHM_V + 2 * SHM_K) + wid * 64; float* li_l = ws; float* al_l = ws + 32;
  float m_reg = -1e30f, l_reg = 0; f32x16 o[4] = {}; bf16x8 qr[8];
  const bf16* Qw = Qb + (long)(wid * QBLK + r32) * LDQ + hi * 8;
#pragma unroll
  for (int d0 = 0; d0 < 8; ++d0) qr[d0] = ld8(Qw + d0 * 16);
  const int sr = tid >> 4, sc = (tid & 15) * 8, vst0 = v_st(sr, sc), vst1 = v_st(32 + sr, sc);
  const int vb0 = (int)(uintptr_t)V_lds + v_rd_base(lane);
  struct { bf16x8 vs0, vs1, ks0, ks1; } sr_[SDEPTH];
#define SLOAD(i, k0) do { sr_[i].vs0 = ld8(&Vh[(long)((k0) + sr) * LDK + sc]); sr_[i].vs1 = ld8(&Vh[(long)((k0) + 32 + sr) * LDK + sc]); \
    sr_[i].ks0 = ld8(&Kh[(long)((k0) + sr) * LDK + sc]); sr_[i].ks1 = ld8(&Kh[(long)((k0) + 32 + sr) * LDK + sc]); } while (0)
#define SWRITE(b, i) do { *(bf16x8*)((char*)V_lds + (b) * SHM_V + vst0) = sr_[i].vs0;          \
    *(bf16x8*)((char*)V_lds + (b) * SHM_V + vst1) = sr_[i].vs1; int kc = sc * 2;               \
    *(bf16x8*)((char*)K_lds + (b) * SHM_K + KSWZ(sr, kc)) = sr_[i].ks0;                       \
    *(bf16x8*)((char*)K_lds + (b) * SHM_K + KSWZ(32 + sr, kc)) = sr_[i].ks1; } while (0)
#define SWAIT() do { if constexpr (SDEPTH == 2) asm volatile("s_waitcnt vmcnt(4)" ::: "memory"); else asm volatile("s_waitcnt vmcnt(0)" ::: "memory"); } while (0)
#define RESC(a) do { if (__any((a) < 1.f)) { if (hi == 0) al_l[r32] = (a); asm volatile("s_waitcnt lgkmcnt(0)" ::: "memory"); \
    for (int d = 0; d < 4; ++d) for (int r = 0; r < 16; ++r) o[d][r] *= al_l[crow(r, hi)]; } } while (0)
  f32x16 pA0, pA1, pB0, pB1; float mnA, mnB, alA, alB; bf16x8 pa0, pa1, pa2, pa3; const int NT = seq / KVBLK;
  constexpr int SE = 0, SO = SDEPTH - 1;
  SLOAD(SE, 0); asm volatile("s_waitcnt vmcnt(0)" ::: "memory"); SWRITE(0, SE); __syncthreads();
  qkt(pA0, pA1, K_lds, qr, r32, hi); partialSM(pA0, pA1, m_reg, mnA, alA);
  SLOAD(SO, KVBLK); if constexpr (SDEPTH == 2) { if (2 < NT) SLOAD(SE, 2 * KVBLK); }
  SWAIT(); SWRITE(1, SO); __syncthreads();
  for (int j = 1; j + 1 < NT; j += 2) {
    SBAR(); qkt(pB0, pB1, (bf16*)((char*)K_lds + SHM_K), qr, r32, hi);
    finishSM(pA0, pA1, alA, l_reg, pa0, pa1, pa2, pa3); SBAR();
    SLOAD(SO, (j + SDEPTH) * KVBLK); SBAR();
    pv_d0(o, vb0, pa0, pa1, pa2, pa3); partialSM(pB0, pB1, m_reg, mnB, alB);
    __syncthreads(); SWAIT(); SWRITE(0, SE);
    RESC(alB); __syncthreads();
    SBAR(); qkt(pA0, pA1, K_lds, qr, r32, hi);
    finishSM(pB0, pB1, alB, l_reg, pa0, pa1, pa2, pa3); SBAR();
    if (SDEPTH == 1 || j + 3 < NT) SLOAD(SE, (j + 1 + SDEPTH) * KVBLK); SBAR();
    pv_d0(o, vb0 + (int)SHM_V, pa0, pa1, pa2, pa3); partialSM(pA0, pA1, m_reg, mnA, alA);
    __syncthreads(); SWAIT(); SWRITE(1, SO);
    RESC(alA); __syncthreads();
  }
  SBAR(); qkt(pB0, pB1, (bf16*)((char*)K_lds + SHM_K), qr, r32, hi);
  finishSM(pA0, pA1, alA, l_reg, pa0, pa1, pa2, pa3); SBAR();
  pv_d0(o, vb0, pa0, pa1, pa2, pa3); partialSM(pB0, pB1, m_reg, mnB, alB);
  __syncthreads(); RESC(alB);
  finishSM(pB0, pB1, alB, l_reg, pa0, pa1, pa2, pa3); SBAR();
  pv_d0(o, vb0 + (int)SHM_V, pa0, pa1, pa2, pa3);
  if (hi == 0) li_l[r32] = l_reg; asm volatile("s_waitcnt lgkmcnt(0)" ::: "memory");
  float rli[16];
#pragma unroll
  for (int r = 0; r < 16; ++r) rli[r] = __builtin_amdgcn_rcpf(li_l[crow(r, hi)]);
  bf16* Ow = Ob + (long)(wid * QBLK) * LDO;
#pragma unroll
  for (int r = 0; r < 16; ++r) { int orow = crow(r, hi);
    for (int d0 = 0; d0 < 4; ++d0) Ow[(long)orow * LDO + d0 * 32 + r32] = __float2bfloat16(o[d0][r] * rli[r]); }
  __syncthreads();
#undef SLOAD
#undef SWRITE
#undef SWAIT
#undef RESC
}
#undef KSWZ
#undef SBAR
}

constexpr int NWAVES = 8;
constexpr int DM = 1024, NTOK = 6144, NPTOK = 4096, TP = 256, TS = 1024, FF = 2816, NGU = 5632, NQKV = 1536, PAST = 512, SKV_S = PAST + TS;
constexpr float EPS = 1e-6f;
enum { I_XP = 0, I_XS, I_C, I_STATE, I_CK, I_CV, I_CCTX, I_MODW, I_MODB, I_NORMG, I_WGU, I_WDN, I_LIN, I_CONVW, I_CONVB, I_GATEW, I_GATEB, I_LAM, I_LOUT, I_WQKV, I_QG, I_KG, I_WO, I_FING, N_IN };
constexpr size_t OUT_Y = 0, OUT_STATE = (size_t)NTOK * DM, OUT_CK = OUT_STATE + 16 * 2 * DM, OUT_CV = OUT_CK + (size_t)NPTOK * 256, OUT_END = OUT_CV + (size_t)NPTOK * 256;
constexpr size_t MiB = 1u << 20;
constexpr size_t WS_CTL = 0, CTL_ZERO_BYTES = 1 * MiB;
constexpr size_t WS_MOD = 1 * MiB;
constexpr size_t WS_WGU = 2 * MiB;
constexpr size_t WS_WDN = WS_WGU + (size_t)4 * NGU * DM * 2;
constexpr size_t WS_WIN = WS_WDN + (size_t)4 * DM * FF * 2;
constexpr size_t WS_WOUT = WS_WIN + (size_t)2048 * DM * 2;
constexpr size_t WS_WQKV = WS_WOUT + (size_t)DM * DM * 2;
constexpr size_t WS_WO = WS_WQKV + (size_t)NQKV * DM * 2;
constexpr size_t WS_GT = WS_WO + (size_t)DM * DM * 2;
constexpr size_t WS_X = 80 * MiB;
constexpr size_t WS_H = 104 * MiB;
constexpr size_t WS_ACT = 116 * MiB;
constexpr size_t WS_P = 150 * MiB;
constexpr size_t WS_AU = 198 * MiB;
constexpr size_t WS_END = 294 * MiB;
static_assert(WS_GT + 4 * 16 * 64 * 64 * 2 <= WS_X, "weights fit below X");
constexpr size_t AT_QKV = WS_AU;
constexpr size_t AT_QB = WS_AU + 36 * MiB;
constexpr size_t AT_KP = WS_AU + 48 * MiB;
constexpr size_t AT_VP = WS_AU + 50 * MiB;
constexpr size_t AT_KS = WS_AU + 52 * MiB;
constexpr size_t AT_VS = WS_AU + 54 * MiB;
constexpr int CW_BAR = 4096;
constexpr int RING_BYTES = 131072, LDSCTL_OFF = RING_BYTES, MISC_OFF = LDSCTL_OFF + 320, LDS_BYTES = 147456;

#define GAS __attribute__((address_space(1)))
#define LAS __attribute__((address_space(3)))
typedef unsigned short bf16;
typedef unsigned v4u __attribute__((ext_vector_type(4)));
typedef float f32x4 __attribute__((ext_vector_type(4)));
typedef short bf16x8 __attribute__((ext_vector_type(8)));
typedef GAS unsigned gu32;
typedef GAS unsigned long long gu64;
#define RLX_AGENT __ATOMIC_RELAXED, __HIP_MEMORY_SCOPE_AGENT
#define LDS_WAIT() asm volatile("s_waitcnt lgkmcnt(0)" ::: "memory")
#define VM_WAIT() asm volatile("s_waitcnt vmcnt(0)" ::: "memory")
__device__ __forceinline__ unsigned long long rt() { return __builtin_amdgcn_s_memrealtime(); }
__device__ __forceinline__ unsigned f2bf(float f) { unsigned u = __builtin_bit_cast(unsigned, f); return (u + 0x7fffu + ((u >> 16) & 1u)) >> 16; }
__device__ __forceinline__ unsigned pk2(float lo, float hi) { return f2bf(lo) | (f2bf(hi) << 16); }

#define XB_TMO      128
#define XB_XCNT(j)  (256  + 64 * (j))
#define XB_XSUB(j)  (1280 + 64 * (j))
#define XB_XGEN(j)  (2304 + 64 * (j))
#define XB_TOP      3328
#define XB_TOPGEN   3392
#define XCD_BAR_WORDS 3456
#define XB_SPIN_CAP (1u << 18)

__device__ __forceinline__ unsigned xb_ld(unsigned* p)              { return __hip_atomic_load(p, __ATOMIC_RELAXED, __HIP_MEMORY_SCOPE_AGENT); }
__device__ __forceinline__ unsigned xb_add(unsigned* p, unsigned v) { return __hip_atomic_fetch_add(p, v, __ATOMIC_RELAXED, __HIP_MEMORY_SCOPE_AGENT); }
__device__ __forceinline__ unsigned xb_xcc_id() { return (unsigned)__builtin_amdgcn_s_getreg((3 << 11) | 20) & 0xFu; }
#define XB_SPIN(cond, bar) do { unsigned _sp = 0; while (cond) { __builtin_amdgcn_s_sleep(1); \
    if ((++_sp & 255u) == 0u) { if (xb_ld(&(bar)[XB_TMO])) break; if (_sp > XB_SPIN_CAP) { atomicAdd(&(bar)[XB_TMO], 1u); break; } } } } while (0)

struct XcdBarrier {
    unsigned* bar; unsigned x;
    volatile LAS unsigned* st;
};

__device__ __forceinline__ XcdBarrier xcd_barrier_post(unsigned* bar, volatile LAS unsigned* st) {
    XcdBarrier b; b.bar = bar; b.x = xb_xcc_id(); b.st = st;
    if (threadIdx.x == 0) (void)xb_add(&bar[XB_XCNT(b.x)], 1u);
    return b;
}
__device__ __forceinline__ void xcd_barrier_complete(unsigned* bar, unsigned x, unsigned& nloc, unsigned& nx) {
    const unsigned G = gridDim.x * gridDim.y * gridDim.z;
    unsigned sum, cnt, mine, sp = 0u;
    for (;;) {
        sum = 0u; cnt = 0u; mine = 0u;
#pragma unroll
        for (unsigned j = 0; j < 16; ++j) { const unsigned c = xb_ld(&bar[XB_XCNT(j)]); sum += c; cnt += (c > 0u) ? 1u : 0u; mine = (j == x) ? c : mine; }
        if (sum == G) break;
        __builtin_amdgcn_s_sleep(1);
        if ((++sp & 255u) == 0u) { if (xb_ld(&bar[XB_TMO])) break; if (sp > XB_SPIN_CAP) { atomicAdd(&bar[XB_TMO], 1u); break; } }
    }
    nloc = mine > 0u ? mine : 1u; nx = cnt > 0u ? cnt : 1u;
}

__device__ __forceinline__ void xcd_barrier(const XcdBarrier& b) {
    asm volatile("s_waitcnt vmcnt(0)" ::: "memory");
    __syncthreads();
    if (threadIdx.x == 0) {
        unsigned* bar = b.bar;
        __builtin_amdgcn_s_waitcnt(0);
        unsigned nloc = b.st[0], nx = b.st[1];
        if (nloc == 0u) { xcd_barrier_complete(bar, b.x, nloc, nx); b.st[0] = nloc; b.st[1] = nx; }
        const unsigned old = xb_add(&bar[XB_XSUB(b.x)], 1u);
        const unsigned gen = old / nloc;
        if (old + 1u == (gen + 1u) * nloc) {
            __builtin_amdgcn_fence(__ATOMIC_RELEASE, "agent");
            asm volatile("s_waitcnt vmcnt(0)" ::: "memory");
            const unsigned og = xb_add(&bar[XB_TOP], 1u);
            const unsigned tg = og / nx;
            if (og + 1u == (tg + 1u) * nx) xb_add(&bar[XB_TOPGEN], 1u);
            else XB_SPIN(xb_ld(&bar[XB_TOPGEN]) == tg, bar);
            __builtin_amdgcn_fence(__ATOMIC_ACQUIRE, "agent");
            xb_add(&bar[XB_XGEN(b.x)], 1u);
            asm volatile("s_waitcnt vmcnt(0)" ::: "memory");
        } else {
            XB_SPIN(xb_ld(&bar[XB_XGEN(b.x)]) == gen, bar);
            __builtin_amdgcn_fence(__ATOMIC_ACQUIRE, "agent");
            asm volatile("s_waitcnt vmcnt(0)" ::: "memory");
        }
    }
    __syncthreads();
}


typedef float f32x16 __attribute__((ext_vector_type(16)));
__device__ __forceinline__ float bf2f(unsigned short h) { return __uint_as_float((unsigned)h << 16); }
__device__ __forceinline__ float wave_sum(float v) {
#pragma unroll
    for (int o = 1; o < 64; o <<= 1) v += __shfl_xor(v, o);
    return v;
}
struct Args { const float* in[N_IN]; float* out; unsigned char* ws; int ph_lo, ph_hi; };

__device__ __forceinline__ void p0_mod(const Args& a, LAS unsigned char* lds, float* MOD, int tid, int lane, int wave) {
    LAS float* sv = (LAS float*)lds;
    LAS float* red = (LAS float*)(lds + 16384);
    const float* c_ctx = a.in[I_CCTX]; const float* cs = a.in[I_C];
    for (int i = tid; i < 3072; i += 512) { const int v = i >> 10, k = i & 1023; const float c = (v == 0) ? c_ctx[k] : cs[(v - 1) * 1024 + k]; sv[i] = c / (1.f + expf(-c)); }
    __syncthreads();
    const float* mod_w = a.in[I_MODW]; const float* mod_b = a.in[I_MODB];
    const int cg = lane & 15, kr = lane >> 4;
    for (int item = blockIdx.x; item < 288; item += gridDim.x) {
        const int l = item / 144, cb = item % 144;
        const float* W = mod_w + (size_t)l * 1024 * 9216 + cb * 64 + cg * 4;
        f32x4 a0 = {0.f, 0.f, 0.f, 0.f}, a1 = a0, a2 = a0;
        const int kbase = wave * 128 + kr;
#pragma unroll 8
        for (int kk = 0; kk < 32; ++kk) { const int k = kbase + 4 * kk; const f32x4 w = *(const f32x4*)(W + (size_t)k * 9216); a0 += sv[k] * w; a1 += sv[1024 + k] * w; a2 += sv[2048 + k] * w; }
#pragma unroll
        for (int j = 0; j < 4; ++j) { a0[j] += __shfl_xor(a0[j], 16); a0[j] += __shfl_xor(a0[j], 32); a1[j] += __shfl_xor(a1[j], 16); a1[j] += __shfl_xor(a1[j], 32); a2[j] += __shfl_xor(a2[j], 16); a2[j] += __shfl_xor(a2[j], 32); }
        if (kr == 0) {
#pragma unroll
            for (int j = 0; j < 4; ++j) { red[(wave * 3 + 0) * 64 + cg * 4 + j] = a0[j]; red[(wave * 3 + 1) * 64 + cg * 4 + j] = a1[j]; red[(wave * 3 + 2) * 64 + cg * 4 + j] = a2[j]; } }
        __syncthreads();
        if (tid < 192) { const int v = tid >> 6, c = tid & 63; float s = mod_b[l * 9216 + cb * 64 + c];
#pragma unroll
            for (int w = 0; w < 8; ++w) s += red[(w * 3 + v) * 64 + c];
            MOD[(l * 3 + v) * 9216 + cb * 64 + c] = s; }
        __syncthreads();
    }
}
__device__ __forceinline__ void tr_item(const float* W, int K, int N, bf16* WT, int drow, int k0, int n0, LAS float* scr, int lane) {
#pragma unroll 8
    for (int i = 0; i < 32; ++i) { const int kk = 2 * i + (lane >> 5); scr[kk * 33 + (lane & 31)] = W[(size_t)(k0 + kk) * N + n0 + (lane & 31)]; }
    LDS_WAIT(); asm volatile("" ::: "memory");
    const int c = lane & 7;
#pragma unroll
    for (int j = 0; j < 4; ++j) { const int n = (lane >> 3) + 8 * j; const LAS float* s = scr + (8 * c) * 33 + n;
        v4u o; o.x = pk2(s[0 * 33], s[1 * 33]); o.y = pk2(s[2 * 33], s[3 * 33]); o.z = pk2(s[4 * 33], s[5 * 33]); o.w = pk2(s[6 * 33], s[7 * 33]);
        *(GAS v4u*)(WT + (size_t)(drow + n) * K + k0 + 8 * c) = o; }
    LDS_WAIT(); asm volatile("" ::: "memory");
}
__device__ __forceinline__ void p0_weights(const Args& a, LAS unsigned char* lds, int gw, int NGW, int wave, int lane) {
    LAS float* scr = (LAS float*)(lds + wave * 16384);
    unsigned char* ws = a.ws;
    constexpr int IGU = 16 * 176, IDN = 44 * 32, IIN = 16 * 64, IOUT = 16 * 32, IQKV = 16 * 48, IO = 16 * 32, IG = 128;
    constexpr int NITEMS = 4 * IGU + 4 * IDN + IIN + IOUT + IQKV + IO + IG;
    for (int it = gw; it < NITEMS; it += NGW) {
        int r = it;
        if (r < 4 * IGU) { const int m = r / IGU, q = r % IGU, kb = q / 176, nb = q % 176, n0 = nb * 32;
            const int drow = (n0 < FF) ? 256 * (n0 / 128) + (n0 % 128) : 256 * ((n0 - FF) / 128) + 128 + ((n0 - FF) % 128);
            tr_item(a.in[I_WGU] + (size_t)m * DM * NGU, DM, NGU, (bf16*)(ws + WS_WGU) + (size_t)m * NGU * DM, drow, kb * 64, n0, scr, lane); continue; } r -= 4 * IGU;
        if (r < 4 * IDN) { const int m = r / IDN, q = r % IDN, kb = q / 32, nb = q % 32;
            tr_item(a.in[I_WDN] + (size_t)m * FF * DM, FF, DM, (bf16*)(ws + WS_WDN) + (size_t)m * DM * FF, nb * 32, kb * 64, nb * 32, scr, lane); continue; } r -= 4 * IDN;
        if (r < IIN) { const int kb = r / 64, nb = r % 64; tr_item(a.in[I_LIN], DM, 2048, (bf16*)(ws + WS_WIN), nb * 32, kb * 64, nb * 32, scr, lane); continue; } r -= IIN;
        if (r < IOUT) { const int kb = r / 32, nb = r % 32; tr_item(a.in[I_LOUT], DM, DM, (bf16*)(ws + WS_WOUT), nb * 32, kb * 64, nb * 32, scr, lane); continue; } r -= IOUT;
        if (r < IQKV) { const int kb = r / 48, nb = r % 48; tr_item(a.in[I_WQKV], DM, NQKV, (bf16*)(ws + WS_WQKV), nb * 32, kb * 64, nb * 32, scr, lane); continue; } r -= IQKV;
        if (r < IO) { const int kb = r / 32, nb = r % 32; tr_item(a.in[I_WO], DM, DM, (bf16*)(ws + WS_WO), nb * 32, kb * 64, nb * 32, scr, lane); continue; } r -= IO;
        { const int mat = r >> 1, nb = r & 1; tr_item(a.in[I_GATEW] + (size_t)mat * 4096, 64, 64, (bf16*)(ws + WS_GT) + (size_t)mat * 4096, nb * 32, 0, nb * 32, scr, lane); }
    }
}

template <int MODE>
__device__ __forceinline__ void norm_phase(const Args& a, int gw, int NGW, int lane, int lg, int sg, float coef, int ln, int sn) {
    unsigned char* ws = a.ws;
    float* X = (float*)(ws + WS_X); const float* P0 = (const float*)(ws + WS_P); const float* P1 = P0 + (size_t)NTOK * DM; const float* MOD = (const float*)(ws + WS_MOD);
    bf16* H = (bf16*)(ws + WS_H);
    for (int row = gw; row < NTOK; row += NGW) {
        const int v = row < NPTOK ? 0 : 1 + ((row - NPTOK) >> 10);
        f32x4 x[4]; float ss = 0.f;
#pragma unroll
        for (int j = 0; j < 4; ++j) { const int c = 4 * lane + 256 * j;
            if (MODE == 0) { x[j] = row < NPTOK ? *(const f32x4*)(a.in[I_XP] + (size_t)row * DM + c) : *(const f32x4*)(a.in[I_XS] + (size_t)(row - NPTOK) * DM + c); }
            else { const f32x4 xo = *(const GAS f32x4*)(X + (size_t)row * DM + c); const f32x4 p = *(const GAS f32x4*)(P0 + (size_t)row * DM + c) + *(const GAS f32x4*)(P1 + (size_t)row * DM + c);
                   const f32x4 gt = *(const GAS f32x4*)(MOD + (size_t)(lg * 3 + v) * 9216 + sg * 3072 + 2048 + c); x[j] = xo + coef * gt * p; }
            ss += (x[j].x * x[j].x + x[j].y * x[j].y) + (x[j].z * x[j].z + x[j].w * x[j].w); }
        const float rstd = 1.0f / sqrtf(wave_sum(ss) * (1.f / DM) + EPS);
#pragma unroll
        for (int j = 0; j < 4; ++j) { const int c = 4 * lane + 256 * j;
            if (MODE == 2) { const f32x4 g = *(const f32x4*)(a.in[I_FING] + c); *(GAS f32x4*)(a.out + OUT_Y + (size_t)row * DM + c) = x[j] * rstd * g; }
            else { *(GAS f32x4*)(X + (size_t)row * DM + c) = x[j];
                   const f32x4 g = *(const f32x4*)(a.in[I_NORMG] + (size_t)(ln * 3 + sn) * DM + c);
                   const f32x4 sh = *(const GAS f32x4*)(MOD + (size_t)(ln * 3 + v) * 9216 + sn * 3072 + c), sc = *(const GAS f32x4*)(MOD + (size_t)(ln * 3 + v) * 9216 + sn * 3072 + 1024 + c);
                   const f32x4 h = (x[j] * rstd) * g * (1.0f + sc) + sh;
                   *(GAS unsigned long long*)(H + (size_t)row * DM + c) = (unsigned long long)pk2(h.x, h.y) | ((unsigned long long)pk2(h.z, h.w) << 32); } }
    }
}

__device__ __forceinline__ void lru_gates_phase(const Args& a, LAS unsigned char* lds, int gw, int NGW, int wave, int lane) {
    unsigned char* ws = a.ws;
    const bf16* XY = (const bf16*)(ws + WS_ACT); const bf16* GT = (const bf16*)(ws + WS_GT); float* AU = (float*)(ws + WS_AU);
    LAS float* xcs = (LAS float*)(lds + wave * 8704);
    const int r32 = lane & 31, hi = lane >> 5;
    for (int task = gw; task < 192 * 16; task += NGW) {
        const int n = task / 192, tc = task % 192, r0 = tc * 32;
        const int s0 = r0 < NPTOK ? (r0 & ~(TP - 1)) : NPTOK + ((r0 - NPTOK) & ~(TS - 1)), T = r0 < NPTOK ? TP : TS;
        { const int col = n * 64 + lane;
          const float w0 = a.in[I_CONVW][0 * DM + col], w1 = a.in[I_CONVW][1 * DM + col], w2 = a.in[I_CONVW][2 * DM + col], w3 = a.in[I_CONVW][3 * DM + col], cb = a.in[I_CONVB][col];
          float xv[35];
#pragma unroll
          for (int i = 0; i < 35; ++i) { const int t = r0 - 1 + i; const bool ok = (t >= s0) && (t < s0 + T); const int tt = ok ? t : r0;
              const float val = bf2f(*(const GAS unsigned short*)(XY + (size_t)tt * 2048 + col)); xv[i] = ok ? val : 0.f; }
#pragma unroll
          for (int j = 0; j < 32; ++j) xcs[j * 68 + lane] = cb + w0 * xv[j] + w1 * xv[j + 1] + w2 * xv[j + 2] + w3 * xv[j + 3];
        }
        LDS_WAIT(); asm volatile("" ::: "memory");
        pg8::bf16x8 af[4];
#pragma unroll
        for (int s = 0; s < 4; ++s) { const LAS f32x4* p = (const LAS f32x4*)(xcs + r32 * 68 + 16 * s + 8 * hi); const f32x4 lo = p[0], hh = p[1];
            v4u w; w.x = pk2(lo.x, lo.y); w.y = pk2(lo.z, lo.w); w.z = pk2(hh.x, hh.y); w.w = pk2(hh.z, hh.w); af[s] = __builtin_bit_cast(pg8::bf16x8, w); }
        f32x16 acc[4][2];
#pragma unroll
        for (int dg = 0; dg < 4; ++dg)
#pragma unroll
            for (int ct = 0; ct < 2; ++ct) { f32x16 c = {};
#pragma unroll
                for (int s = 0; s < 4; ++s) { const pg8::bf16x8 bfr = *(const GAS pg8::bf16x8*)(GT + ((size_t)(dg * 16 + n) * 64 + ct * 32 + r32) * 64 + 16 * s + 8 * hi);
                    c = __builtin_amdgcn_mfma_f32_32x32x16_bf16(af[s], bfr, c, 0, 0, 0); }
                acc[dg][ct] = c; }
#pragma unroll
        for (int ct = 0; ct < 2; ++ct) { const int ch = n * 64 + ct * 32 + r32;
#pragma unroll
            for (int d = 0; d < 2; ++d) {
                const float gbr = a.in[I_GATEB][(d * 2 + 0) * DM + ch], gbi = a.in[I_GATEB][(d * 2 + 1) * DM + ch];
                const float lam = a.in[I_LAM][d * DM + ch]; const float ls = -log1pf(expf(-lam));
                float* Aq = AU + (size_t)(2 * d) * NTOK * DM + ch; float* Uq = AU + (size_t)(2 * d + 1) * NTOK * DM + ch;
#pragma unroll
                for (int r = 0; r < 16; ++r) { const int tl = (r & 3) + 8 * (r >> 2) + 4 * hi;
                    const float xc = xcs[tl * 68 + ct * 32 + r32];
                    const float rg = 1.0f / (1.0f + expf(-(acc[2 * d][ct][r] + gbr))), ig = 1.0f / (1.0f + expf(-(acc[2 * d + 1][ct][r] + gbi)));
                    const float la = 8.0f * rg * ls; const float av = expf(la); const float mult = sqrtf(fmaxf(-expm1f(2.0f * la), 0.f));
                    Aq[(size_t)(r0 + tl) * DM] = av; Uq[(size_t)(r0 + tl) * DM] = mult * (ig * xc); } } }
        LDS_WAIT(); asm volatile("" ::: "memory");
    }
}

__device__ __forceinline__ float gelu_tanh(float x) { const float z = 0.7978845608028654f * (x + 0.044715f * x * x * x); return x / (1.0f + expf(-2.0f * z)); }
__device__ __forceinline__ void lru_scan_phase(const Args& a, int tid, int wave, int lane) {
    unsigned char* ws = a.ws;
    const float* AU = (const float*)(ws + WS_AU); float* HF = (float*)(ws + WS_P); float* HB = HF + (size_t)NTOK * DM;
    const bf16* XY = (const bf16*)(ws + WS_ACT); bf16* Y = (bf16*)(ws + WS_H);
    for (int task = blockIdx.x; task < 288; task += gridDim.x) {
        const bool smp = task < 32; const int bs = task >> 4, n = task & 15;
        const int s0 = smp ? NPTOK + bs * TS : (bs - 2) * TP, T = smp ? TS : TP;
        const int col = n * 64 + lane;
        if (wave < 2) {
            const int d = wave;
            const float* Aq = AU + (size_t)(2 * d) * NTOK * DM + col; const float* Uq = AU + (size_t)(2 * d + 1) * NTOK * DM + col;
            float* Hq = (d == 0 ? HF : HB) + col;
            float h = smp ? a.in[I_STATE][(bs * 2 + d) * DM + col] : 0.f;
            const int nch = T / 16;
            float av[16], uv[16], an[16], un[16];
            { const int base = d == 0 ? s0 : s0 + T - 16;
#pragma unroll
              for (int i = 0; i < 16; ++i) { av[i] = Aq[(size_t)(base + i) * DM]; uv[i] = Uq[(size_t)(base + i) * DM]; } }
            for (int c = 0; c < nch; ++c) {
                const int base = d == 0 ? s0 + 16 * c : s0 + T - 16 - 16 * c;
                const int cn = (c + 1 < nch) ? c + 1 : c; const int nbase = d == 0 ? s0 + 16 * cn : s0 + T - 16 - 16 * cn;
#pragma unroll
                for (int i = 0; i < 16; ++i) { an[i] = Aq[(size_t)(nbase + i) * DM]; un[i] = Uq[(size_t)(nbase + i) * DM]; }
                if (d == 0) {
#pragma unroll
                    for (int i = 0; i < 16; ++i) { h = av[i] * h + uv[i]; Hq[(size_t)(base + i) * DM] = h; }
                } else {
#pragma unroll
                    for (int i = 15; i >= 0; --i) { h = av[i] * h + uv[i]; Hq[(size_t)(base + i) * DM] = h; }
                }
#pragma unroll
                for (int i = 0; i < 16; ++i) { av[i] = an[i]; uv[i] = un[i]; }
            }
            if (!smp) a.out[OUT_STATE + (size_t)((bs - 2) * 2 + d) * DM + col] = h;
        }
        __syncthreads();
        for (int t = wave; t < T; t += 8) { const size_t row = (size_t)(s0 + t);
            const float hf = *(const GAS float*)(HF + row * DM + col), hb = *(const GAS float*)(HB + row * DM + col);
            const float yb = bf2f(*(const GAS unsigned short*)(XY + row * 2048 + 1024 + col));
            *(GAS unsigned short*)(Y + row * DM + col) = (unsigned short)f2bf((hf + hb) * gelu_tanh(yb)); }
        __syncthreads();
    }
}

__device__ __forceinline__ void qk_pack_phase(const Args& a, int gw, int NGW, int lane) {
    unsigned char* ws = a.ws;
    const float* QKV = (const float*)(ws + AT_QKV); bf16* QB = (bf16*)(ws + AT_QB); bf16* KP = (bf16*)(ws + AT_KP); bf16* VP = (bf16*)(ws + AT_VP); bf16* KS = (bf16*)(ws + AT_KS); bf16* VS = (bf16*)(ws + AT_VS);
    const int grp = lane >> 4, j = lane & 15;
    for (int task = gw; task < NTOK + 2 * PAST; task += NGW) {
        if (task >= NTOK) {
            const int i = task - NTOK, b = i / PAST, t = i % PAST;
            const f32x4 k4 = *(const f32x4*)(a.in[I_CK] + (size_t)i * 256 + 4 * lane), v4 = *(const f32x4*)(a.in[I_CV] + (size_t)i * 256 + 4 * lane);
            const size_t o = ((size_t)b * SKV_S + t) * 256 + 4 * lane;
            *(GAS unsigned long long*)(KS + o) = (unsigned long long)pk2(k4.x, k4.y) | ((unsigned long long)pk2(k4.z, k4.w) << 32);
            *(GAS unsigned long long*)(VS + o) = (unsigned long long)pk2(v4.x, v4.y) | ((unsigned long long)pk2(v4.z, v4.w) << 32);
            continue;
        }
        const int row = task; const bool smp = row >= NPTOK; const int bsm = smp ? (row - NPTOK) >> 10 : 0, t = smp ? (row - NPTOK) & (TS - 1) : 0;
        const float pos = (float)((j < 8) ? (t >> 6) : (t & 63));
#pragma unroll
        for (int rd = 0; rd < 3; ++rd) {
            const int hh = rd * 4 + grp;
            const GAS f32x4* src = (const GAS f32x4*)(QKV + (size_t)row * NQKV + hh * 128 + 8 * j);
            const f32x4 lo = src[0], hv = src[1];
            float x[8] = {lo.x, lo.y, lo.z, lo.w, hv.x, hv.y, hv.z, hv.w};
            float ss = 0.f;
#pragma unroll
            for (int e = 0; e < 8; ++e) ss += x[e] * x[e];
            ss += __shfl_xor(ss, 1); ss += __shfl_xor(ss, 2); ss += __shfl_xor(ss, 4); ss += __shfl_xor(ss, 8);
            const float rstd = 1.0f / sqrtf(ss * (1.f / 128.f) + EPS);
            const float* gsrc = (hh < 8) ? a.in[I_QG] : a.in[I_KG];
            float y[8];
#pragma unroll
            for (int e = 0; e < 8; ++e) y[e] = (hh < 10) ? x[e] * rstd * gsrc[8 * j + e] : x[e];
            if (smp) {
                float rr[8];
#pragma unroll
                for (int e = 0; e < 8; ++e) { const float other = __shfl_xor(y[e], 4);
                    const float inv = exp2f(-(float)(8 * (j & 3) + e) * (13.287712379549449f / 32.f)); float sn, cs; sincosf(pos * inv, &sn, &cs);
                    rr[e] = ((j & 4) == 0) ? (y[e] * cs - other * sn) : (other * sn + y[e] * cs); }
                if (hh < 10) {
#pragma unroll
                    for (int e = 0; e < 8; ++e) y[e] = rr[e]; }
            }
            v4u w; w.x = pk2(y[0], y[1]); w.y = pk2(y[2], y[3]); w.z = pk2(y[4], y[5]); w.w = pk2(y[6], y[7]);
            if (hh < 8) { *(GAS v4u*)(QB + (size_t)row * DM + hh * 128 + 8 * j) = w; }
            else { const bool isk = hh < 10; const int kvh = isk ? hh - 8 : hh - 10;
                if (!smp) { float* o = a.out + (isk ? OUT_CK : OUT_CV) + (size_t)row * 256 + kvh * 128 + 8 * j;
                    *(GAS f32x4*)o = (f32x4){y[0], y[1], y[2], y[3]}; *(GAS f32x4*)(o + 4) = (f32x4){y[4], y[5], y[6], y[7]};
                    *(GAS v4u*)((isk ? KP : VP) + (size_t)row * 256 + kvh * 128 + 8 * j) = w; }
                else { *(GAS v4u*)((isk ? KS : VS) + ((size_t)bsm * SKV_S + PAST + t) * 256 + kvh * 128 + 8 * j) = w; } }
        }
    }
}

__device__ __forceinline__ void attn_phase(const Args& a, char* lds) {
    unsigned char* ws = a.ws;
    const att::bf16* QB = (const att::bf16*)(ws + AT_QB); const att::bf16* KP = (const att::bf16*)(ws + AT_KP); const att::bf16* VP = (const att::bf16*)(ws + AT_VP);
    const att::bf16* KS = (const att::bf16*)(ws + AT_KS); const att::bf16* VS = (const att::bf16*)(ws + AT_VS); att::bf16* O = (att::bf16*)(ws + WS_H);
    for (int u = blockIdx.x; u < 192; u += gridDim.x) {
        if (u < 64) { const int b = u >> 5, h = (u & 31) >> 2, qb = u & 3; const size_t q0 = ((size_t)NPTOK + b * TS + qb * 256) * DM + h * 128, k0 = (size_t)b * SKV_S * 256 + (h >> 2) * 128;
            att::attn_dense_body(QB + q0, KS + k0, VS + k0, O + q0, SKV_S, lds); }
        else { const int p = u - 64, b = p >> 3, h = p & 7; const size_t q0 = (size_t)b * TP * DM + h * 128, k0 = (size_t)b * TP * 256 + (h >> 2) * 128;
            att::attn_dense_body(QB + q0, KP + k0, VP + k0, O + q0, TP, lds); }
    }
}

constexpr int N_PHASES = 24;
__global__ void __launch_bounds__(NWAVES * 64, 2) mk_fwd(Args args) {
    extern __shared__ __attribute__((aligned(16))) unsigned char lds[];
    LAS unsigned char* L = (LAS unsigned char*)lds;
    volatile LAS unsigned* MISC = (volatile LAS unsigned*)(L + MISC_OFF);
    const int tid = threadIdx.x, lane = tid & 63, wave = __builtin_amdgcn_readfirstlane(tid >> 6);
    const int G = gridDim.x, gw = blockIdx.x * NWAVES + wave, NGW = G * NWAVES;
    unsigned char* ws = args.ws;
    gu32* ctl = (gu32*)(ws + WS_CTL);
    for (int u = tid; u < (LDS_BYTES - LDSCTL_OFF) / 4; u += NWAVES * 64) ((LAS unsigned*)(L + LDSCTL_OFF))[u] = 0u;
    __syncthreads();
    XcdBarrier bar; bar.bar = (unsigned*)(ctl + CW_BAR); bar.x = 0; bar.st = nullptr;
    if (!MK_PER_PHASE) bar = xcd_barrier_post((unsigned*)(ctl + CW_BAR), MISC + 8);
    const int lo = args.ph_lo, hi = args.ph_hi;
#define IN(k) (lo <= (k) && (k) < hi)
#define SEAM(k) do { if (IN(k) && IN((k) + 1)) xcd_barrier(bar); } while (0)
    bf16* H = (bf16*)(ws + WS_H); bf16* ACT = (bf16*)(ws + WS_ACT); float* P = (float*)(ws + WS_P);
    const bf16* WGU = (const bf16*)(ws + WS_WGU); const bf16* WDN = (const bf16*)(ws + WS_WDN);

#define FFN_UP(k, m) if (IN(k)) { pg8::Gemm g{H, WGU + (size_t)(m) * NGU * DM, NTOK, NGU, DM, DM, 1}; pg8::StaticOrder S; S.init(NTOK, NGU, 1, G, (int)blockIdx.x); \
        pg8::EpiSwiglu E{ACT, FF}; pg8::gemm_phase<pg8::EpiSwiglu, pg8::StaticOrder, true, true>(L, g, S, E); } SEAM(k)
#define FFN_DOWN(k, m) if (IN(k)) { pg8::Gemm g{ACT, WDN + (size_t)(m) * DM * FF, NTOK, DM, FF / 2, FF, 2}; pg8::StaticOrder S; S.init(NTOK, DM, 2, G, (int)blockIdx.x); \
        pg8::EpiF32Slab E{P, (size_t)NTOK * DM, DM}; pg8::gemm_phase<pg8::EpiF32Slab, pg8::StaticOrder, true, true>(L, g, S, E); } SEAM(k)
#define PROJ_OUT(k, Wt) if (IN(k)) { pg8::Gemm g{H, (const bf16*)(ws + (Wt)), NTOK, DM, DM / 2, DM, 2}; pg8::StaticOrder S; S.init(NTOK, DM, 2, G, (int)blockIdx.x); \
        pg8::EpiF32Slab E{P, (size_t)NTOK * DM, DM}; pg8::gemm_phase<pg8::EpiF32Slab, pg8::StaticOrder, true, true>(L, g, S, E); } SEAM(k)

    if (IN(0)) { p0_mod(args, L, (float*)(ws + WS_MOD), tid, lane, wave); __syncthreads(); p0_weights(args, L, gw, NGW, wave, lane); } SEAM(0);
    if (IN(1)) norm_phase<0>(args, gw, NGW, lane, 0, 0, 0.f, 0, 0); SEAM(1);
    FFN_UP(2, 0); FFN_DOWN(3, 0);
    if (IN(4)) norm_phase<1>(args, gw, NGW, lane, 0, 0, 0.5f, 0, 1); SEAM(4);
    if (IN(5)) { pg8::Gemm g{H, (const bf16*)(ws + WS_WIN), NTOK, 2048, DM, DM, 1}; pg8::StaticOrder S; S.init(NTOK, 2048, 1, G, (int)blockIdx.x);
        pg8::EpiStoreBf16 E{ACT, 2048}; pg8::gemm_phase<pg8::EpiStoreBf16, pg8::StaticOrder, true, true>(L, g, S, E); } SEAM(5);
    if (IN(6)) lru_gates_phase(args, L, gw, NGW, wave, lane); SEAM(6);
    if (IN(7)) lru_scan_phase(args, tid, wave, lane); SEAM(7);
    PROJ_OUT(8, WS_WOUT);
    if (IN(9)) norm_phase<1>(args, gw, NGW, lane, 0, 1, 1.0f, 0, 2); SEAM(9);
    FFN_UP(10, 1); FFN_DOWN(11, 1);
    if (IN(12)) norm_phase<1>(args, gw, NGW, lane, 0, 2, 0.5f, 1, 0); SEAM(12);
    FFN_UP(13, 2); FFN_DOWN(14, 2);
    if (IN(15)) norm_phase<1>(args, gw, NGW, lane, 1, 0, 0.5f, 1, 1); SEAM(15);
    if (IN(16)) { pg8::Gemm g{H, (const bf16*)(ws + WS_WQKV), NTOK, NQKV, DM, DM, 1}; pg8::StaticOrder S; S.init(NTOK, NQKV, 1, G, (int)blockIdx.x);
        pg8::EpiF32Slab E{(float*)(ws + AT_QKV), 0, NQKV}; pg8::gemm_phase<pg8::EpiF32Slab, pg8::StaticOrder, true, true>(L, g, S, E); } SEAM(16);
    if (IN(17)) qk_pack_phase(args, gw, NGW, lane); SEAM(17);
    if (IN(18)) attn_phase(args, (char*)lds); SEAM(18);
    PROJ_OUT(19, WS_WO);
    if (IN(20)) norm_phase<1>(args, gw, NGW, lane, 1, 1, 1.0f, 1, 2); SEAM(20);
    FFN_UP(21, 3); FFN_DOWN(22, 3);
    if (IN(23)) norm_phase<2>(args, gw, NGW, lane, 1, 2, 0.5f, 0, 0);
#undef IN
#undef SEAM
}

extern "C" void kernel_launch(void* const* d_in, const int* in_sizes, int n_in, void* d_out, int out_size, void* d_ws, size_t ws_size, hipStream_t stream) {
    static int grid = 0;
    if (grid == 0) {
        if (n_in != N_IN || out_size != (int)OUT_END || ws_size < WS_END) { fprintf(stderr, "kernel_launch: unexpected shapes: n_in %d out %d ws %zu (need %zu)\n", n_in, out_size, ws_size, (size_t)WS_END); grid = -1; return; }
        int dev = 0, cus = 0;
        if (hipGetDevice(&dev) != hipSuccess || hipDeviceGetAttribute(&cus, hipDeviceAttributeMultiprocessorCount, dev) != hipSuccess) { grid = -1; return; }
        if (hipFuncSetAttribute((const void*)mk_fwd, hipFuncAttributeMaxDynamicSharedMemorySize, LDS_BYTES) != hipSuccess) { fprintf(stderr, "kernel_launch: hipFuncSetAttribute failed\n"); grid = -1; return; }
        int per_cu = 0;
        if (hipOccupancyMaxActiveBlocksPerMultiprocessor(&per_cu, (const void*)mk_fwd, NWAVES * 64, LDS_BYTES) != hipSuccess || per_cu < 1) fprintf(stderr, "kernel_launch: occupancy query reports %d\n", per_cu);
        (void)hipGetLastError();
        grid = cus;
    }
    if (grid < 0) return;
    (void)hipMemsetAsync((char*)d_ws + WS_CTL, 0, CTL_ZERO_BYTES, stream);
    Args a{};
    for (int i = 0; i < N_IN; ++i) a.in[i] = (const float*)d_in[i];
    a.out = (float*)d_out; a.ws = (unsigned char*)d_ws;
#if MK_PER_PHASE
    for (int p = 0; p < N_PHASES; ++p) { a.ph_lo = p; a.ph_hi = p + 1; hipLaunchKernelGGL(mk_fwd, dim3(grid), dim3(NWAVES * 64), LDS_BYTES, stream, a); }
#else
    a.ph_lo = 0; a.ph_hi = N_PHASES;
    hipLaunchKernelGGL(mk_fwd, dim3(grid), dim3(NWAVES * 64), LDS_BYTES, stream, a);
#endif
    const hipError_t le = hipPeekAtLastError();
    if (le != hipSuccess) fprintf(stderr, "kernel_launch: launch failed: %s\n", hipGetErrorName(le));
}
```

```cpp
#include <hip/hip_runtime.h>
#include <hip/hip_bf16.h>
#include <cstdio>
#include <cstdint>

#ifndef PROBE_MASK
#define PROBE_MASK 0u
#endif
#ifndef MK_PER_PHASE
#define MK_PER_PHASE 0
#endif

namespace pg8 {
#define PG8_LAS __attribute__((address_space(3)))
typedef unsigned short bf16_t;
typedef short bf16x8 __attribute__((ext_vector_type(8)));
typedef float f32x4 __attribute__((ext_vector_type(4)));
typedef unsigned u32x4 __attribute__((ext_vector_type(4)));
constexpr int BM = 256, BK = 64, HALF = 128, HTB = HALF * BK * 2  , STAGE_BYTES = 8 * HTB, NXCD = 8, WGM = 8;

__host__ __device__ __forceinline__ int lds_byte(int r, int c) { const int st = (r >> 4) * 2 + (c >> 5), rr = r & 15, cc = c & 31, ob = rr * 64 + cc * 2; return st * 1024 + (ob ^ (((ob >> 9) & 1) << 5)); }
__host__ __device__ __forceinline__ void stage_rc(int b, int& R, int& C) { const int st = b / 1024, sb = b % 1024, swz = sb ^ (((sb >> 9) & 1) << 5); R = (st >> 1) * 16 + swz / 64; C = (st & 1) * 32 + (swz % 64) / 2; }
__host__ __device__ __forceinline__ int perm32(int rho) { const int n = rho >> 4, i = rho & 15; return 8 * (i >> 2) + 4 * n + (i & 3); }

struct Unit { int pm, pn, kz; };
struct Gemm { const bf16_t* A; const bf16_t* Bt; int M, N, K, ld, nz; };

struct StaticOrder {
    int nM, nN, nmn, nwg, G, c;
    __host__ __device__ void init(int M, int N, int nz, int G_, int c_) { nM = M / BM; nN = N / BM; nmn = nM * nN; nwg = nmn * nz; G = G_; c = c_; }
    __host__ __device__ bool next(int i, Unit& u) const {
        const long L = (long)i * G + c; if (L >= nwg) return false;
        u.kz = (int)(L / nmn);
        int wgid = (int)(L % nmn); { const int q = nmn / NXCD, r = nmn % NXCD, xcd = wgid % NXCD, off = wgid / NXCD; wgid = (xcd < r ? xcd * (q + 1) : r * (q + 1) + (xcd - r) * q) + off; }
        const int nig = WGM * nN, gid = wgid / nig, fm = gid * WGM, gsz = (nM - fm) < WGM ? (nM - fm) : WGM;
        u.pm = fm + ((wgid % nig) % gsz); u.pn = (wgid % nig) / gsz; return true;
    }
    __device__ __forceinline__ void a_ready(const Unit&) const {}
    __device__ __forceinline__ void done(const Unit&) const {}
};

__device__ __forceinline__ unsigned cvt_pk_bf16(float lo, float hi) { unsigned r; asm volatile("v_cvt_pk_bf16_f32 %0, %1, %2" : "=v"(r) : "v"(lo), "v"(hi)); return r; }

struct EpiStoreBf16 {
    static constexpr bool PERM = true, AFTER_DRAIN = false;
    bf16_t* O; int ldc;
    __device__ __forceinline__ void operator()(const f32x4 (&acc)[2][2][4][2], const Unit& u, int wr, int wc, int fr, int fq) const {
        const int row0 = u.pm * BM + wr * 64 + fr, col0 = u.pn * BM + wc * 32 + 8 * fq;
#pragma unroll
        for (int ai = 0; ai < 2; ++ai)
#pragma unroll
            for (int m = 0; m < 4; ++m) { bf16_t* rowp = O + (size_t)(row0 + ai * HALF + m * 16) * ldc + col0;
#pragma unroll
                for (int bj = 0; bj < 2; ++bj) { const f32x4 v0 = acc[ai][bj][m][0], v1 = acc[ai][bj][m][1];
                    u32x4 w; w.x = cvt_pk_bf16(v0[0], v0[1]); w.y = cvt_pk_bf16(v0[2], v0[3]); w.z = cvt_pk_bf16(v1[0], v1[1]); w.w = cvt_pk_bf16(v1[2], v1[3]);
                    *(u32x4*)(rowp + bj * HALF) = w; } }
    }
};
__device__ __forceinline__ float silu_mul(float g, float u) { return g * u * __builtin_amdgcn_rcpf(1.0f + __builtin_amdgcn_exp2f(-1.4426950408889634f * g)); }
struct EpiSwiglu {
    static constexpr bool PERM = true, AFTER_DRAIN = false;
    bf16_t* O; int ldc;
    __device__ __forceinline__ void operator()(const f32x4 (&acc)[2][2][4][2], const Unit& u, int wr, int wc, int fr, int fq) const {
        const int row0 = u.pm * BM + wr * 64 + fr, col0 = u.pn * HALF + wc * 32 + 8 * fq;
#pragma unroll
        for (int ai = 0; ai < 2; ++ai)
#pragma unroll
            for (int m = 0; m < 4; ++m) { bf16_t* rowp = O + (size_t)(row0 + ai * HALF + m * 16) * ldc + col0;
                const f32x4 g0 = acc[ai][0][m][0], g1 = acc[ai][0][m][1], u0 = acc[ai][1][m][0], u1 = acc[ai][1][m][1];
                u32x4 w; w.x = cvt_pk_bf16(silu_mul(g0[0], u0[0]), silu_mul(g0[1], u0[1])); w.y = cvt_pk_bf16(silu_mul(g0[2], u0[2]), silu_mul(g0[3], u0[3]));
                w.z = cvt_pk_bf16(silu_mul(g1[0], u1[0]), silu_mul(g1[1], u1[1])); w.w = cvt_pk_bf16(silu_mul(g1[2], u1[2]), silu_mul(g1[3], u1[3]));
                *(u32x4*)rowp = w; }
    }
};
struct EpiF32Slab {
    static constexpr bool PERM = false, AFTER_DRAIN = false;
    float* C; size_t slab; int ldc;
    __device__ __forceinline__ void operator()(const f32x4 (&acc)[2][2][4][2], const Unit& u, int wr, int wc, int fr, int fq) const {
        const int row0 = u.pm * BM + wr * 64 + fr, col0 = u.pn * BM + wc * 32 + 4 * fq; float* Cz = C + (size_t)u.kz * slab;
#pragma unroll
        for (int ai = 0; ai < 2; ++ai)
#pragma unroll
            for (int m = 0; m < 4; ++m) { float* rowp = Cz + (size_t)(row0 + ai * HALF + m * 16) * ldc + col0;
#pragma unroll
                for (int bj = 0; bj < 2; ++bj)
#pragma unroll
                    for (int n = 0; n < 2; ++n) *(f32x4*)(rowp + bj * HALF + n * 16) = acc[ai][bj][m][n]; }
    }
};

template <class Epi, class Sched, bool ALIGN_EPI = false, bool SP2 = false>
__device__ __forceinline__ void gemm_phase(PG8_LAS unsigned char* lds, const Gemm g, const Sched& S, const Epi& E) {
    const int tid = threadIdx.x, wid = __builtin_amdgcn_readfirstlane(tid >> 6), lane = tid & 63, wr = wid >> 2, wc = wid & 3, fr = lane & 15, fq = lane >> 4;
    const int K = g.K, LD = g.ld, nt = K / BK;
    unsigned voffA[2], voffB[2];
#pragma unroll
    for (int i = 0; i < 2; ++i) { int R, C; stage_rc(tid * 16 + i * 8192, R, C); const int Rb = Epi::PERM ? ((R & ~31) + perm32(R & 31)) : R;
        voffA[i] = (unsigned)(R * LD + C) * 2u; voffB[i] = (unsigned)(Rb * LD + C) * 2u; }
    const size_t kstep = (size_t)(BK * 2);
    const size_t hstep = (size_t)HALF * LD * 2;
    const size_t tstep = 2 * hstep;
    const unsigned ldsw = (unsigned)wid * 1024u;
    const int aoff = lds_byte(wr * 64 + fr, fq * 8), boff = lds_byte(wc * 32 + fr, fq * 8);
#define PG8_SA(b, h) (((b) * 2 + (h)) * HTB)
#define PG8_SB(b, h) ((4 + (b) * 2 + (h)) * HTB)
#define PG8_STAGE(bufoff, gbase, voff) do { _Pragma("unroll") for (int _i = 0; _i < 2; ++_i) \
        __builtin_amdgcn_global_load_lds((const unsigned*)((const char*)(gbase) + (voff)[_i]), (PG8_LAS unsigned*)(lds + (bufoff) + ldsw + _i * 8192), 16, 0, 0); } while (0)
#define PG8_LDA(dst, b, h) do { _Pragma("unroll") for (int m = 0; m < 4; ++m) _Pragma("unroll") for (int k = 0; k < 2; ++k) dst[m][k] = *(const PG8_LAS bf16x8*)(lds + PG8_SA(b, h) + aoff + m * 2048 + k * 1024); } while (0)
#define PG8_LDB(dst, b, h) do { _Pragma("unroll") for (int n = 0; n < 2; ++n) _Pragma("unroll") for (int k = 0; k < 2; ++k) dst[n][k] = *(const PG8_LAS bf16x8*)(lds + PG8_SB(b, h) + boff + n * 2048 + k * 1024); } while (0)
#define PG8_MMA(ai, bj, At, Bt) do { __builtin_amdgcn_s_setprio(1); _Pragma("unroll") for (int m = 0; m < 4; ++m) _Pragma("unroll") for (int n = 0; n < 2; ++n) _Pragma("unroll") for (int k = 0; k < 2; ++k) \
        acc[ai][bj][m][n] = __builtin_amdgcn_mfma_f32_16x16x32_bf16(Bt[n][k], At[m][k], acc[ai][bj][m][n], 0, 0, 0); __builtin_amdgcn_s_setprio(0); } while (0)
#define PG8_WAIT_V(n) asm volatile("s_waitcnt vmcnt(" #n ")" ::: "memory")
#define PG8_WAIT_L(n) asm volatile("s_waitcnt lgkmcnt(" #n ")" ::: "memory")
#define PG8_BAR __builtin_amdgcn_s_barrier()
#define PG8_SCHED __builtin_amdgcn_sched_barrier(0)
    Unit cur, nxt; int ui = 0;
    if (!S.next(0, cur)) return;
    f32x4 acc[2][2][4][2];
#pragma unroll
    for (int a = 0; a < 2; ++a)
#pragma unroll
        for (int b = 0; b < 2; ++b)
#pragma unroll
            for (int m = 0; m < 4; ++m)
#pragma unroll
                for (int n = 0; n < 2; ++n) acc[a][b][m][n] = (f32x4){0.f, 0.f, 0.f, 0.f};
    bf16x8 At[4][2], B0[2][2], B1[2][2];
    const char* cA = (const char*)g.A + (size_t)cur.pm * tstep + (size_t)cur.kz * K * 2; const char* cB = (const char*)g.Bt + (size_t)cur.pn * tstep + (size_t)cur.kz * K * 2;
    S.a_ready(cur);
    if constexpr (SP2) {
        PG8_STAGE(PG8_SB(0, 0), cB, voffB); PG8_STAGE(PG8_SB(0, 1), cB + hstep, voffB); PG8_STAGE(PG8_SA(0, 0), cA, voffA); PG8_STAGE(PG8_SA(0, 1), cA + hstep, voffA);
        if (wr == 1) PG8_BAR;
        PG8_WAIT_V(2); PG8_BAR;
        PG8_STAGE(PG8_SB(1, 0), cB + kstep, voffB); PG8_STAGE(PG8_SA(1, 0), cA + kstep, voffA); PG8_STAGE(PG8_SB(1, 1), cB + hstep + kstep, voffB);
        PG8_WAIT_V(6); PG8_BAR;
    } else {
        PG8_STAGE(PG8_SB(0, 0), cB, voffB); PG8_STAGE(PG8_SA(0, 0), cA, voffA); PG8_STAGE(PG8_SB(0, 1), cB + hstep, voffB); PG8_STAGE(PG8_SA(0, 1), cA + hstep, voffA);
        if (wr == 1) PG8_BAR;
        PG8_WAIT_V(4); PG8_BAR;
        PG8_STAGE(PG8_SB(1, 0), cB + kstep, voffB); PG8_STAGE(PG8_SA(1, 0), cA + kstep, voffA); PG8_STAGE(PG8_SB(1, 1), cB + hstep + kstep, voffB);
        PG8_WAIT_V(6); PG8_BAR;
    }
    for (;;) {
        const bool has_next = S.next(ui + 1, nxt);
        const char* nA = has_next ? (const char*)g.A + (size_t)nxt.pm * tstep + (size_t)nxt.kz * K * 2 : cA; const char* nB = has_next ? (const char*)g.Bt + (size_t)nxt.pn * tstep + (size_t)nxt.kz * K * 2 : cB;
        for (int t = 0; t < nt; t += 2) {
            const bool last = (t == nt - 2);
            const char* a1 = cA + (size_t)(t + 1) * kstep;
            const char* a2 = last ? nA : cA + (size_t)(t + 2) * kstep; const char* b2 = last ? nB : cB + (size_t)(t + 2) * kstep;
            const char* a3 = a2 + kstep; const char* b3 = b2 + kstep;
            if (last && has_next) S.a_ready(nxt);
            if constexpr (SP2) {
            PG8_LDB(B0, 0, 0); PG8_LDB(B1, 0, 1); PG8_SCHED; PG8_LDA(At, 0, 0); PG8_STAGE(PG8_SA(1, 1), a1 + hstep, voffA);
            PG8_WAIT_V(8); PG8_WAIT_L(0); PG8_BAR; PG8_MMA(0, 0, At, B0); PG8_MMA(0, 1, At, B1); PG8_BAR; PG8_SCHED;
            PG8_LDA(At, 0, 1); PG8_STAGE(PG8_SB(0, 0), b2, voffB); PG8_STAGE(PG8_SB(0, 1), b2 + hstep, voffB); PG8_STAGE(PG8_SA(0, 0), a2, voffA);
            PG8_WAIT_V(8); PG8_WAIT_L(0); PG8_BAR; PG8_MMA(1, 0, At, B0); PG8_MMA(1, 1, At, B1); PG8_BAR; PG8_SCHED;
            PG8_LDB(B0, 1, 0); PG8_LDB(B1, 1, 1); PG8_SCHED; PG8_LDA(At, 1, 0); PG8_STAGE(PG8_SA(0, 1), a2 + hstep, voffA);
            PG8_WAIT_V(8); PG8_WAIT_L(0); PG8_BAR; PG8_MMA(0, 0, At, B0); PG8_MMA(0, 1, At, B1); PG8_BAR; PG8_SCHED;
            PG8_LDA(At, 1, 1); PG8_STAGE(PG8_SB(1, 0), b3, voffB); PG8_STAGE(PG8_SB(1, 1), b3 + hstep, voffB); PG8_STAGE(PG8_SA(1, 0), a3, voffA);
            PG8_WAIT_V(8); PG8_WAIT_L(0); PG8_BAR; PG8_MMA(1, 0, At, B0); PG8_MMA(1, 1, At, B1); PG8_BAR; PG8_SCHED;
            } else {
            PG8_LDB(B0, 0, 0); PG8_SCHED; PG8_LDA(At, 0, 0); PG8_STAGE(PG8_SA(1, 1), a1 + hstep, voffA);
            PG8_WAIT_L(8); PG8_BAR; PG8_WAIT_L(0); PG8_MMA(0, 0, At, B0); PG8_BAR; PG8_SCHED;
            PG8_LDB(B1, 0, 1); PG8_STAGE(PG8_SB(0, 0), b2, voffB);
            PG8_BAR; PG8_WAIT_L(0); PG8_MMA(0, 1, At, B1); PG8_BAR;
            PG8_LDA(At, 0, 1); PG8_STAGE(PG8_SA(0, 0), a2, voffA);
            PG8_BAR; PG8_WAIT_L(0); PG8_MMA(1, 0, At, B0); PG8_BAR; PG8_SCHED;
            PG8_STAGE(PG8_SB(0, 1), b2 + hstep, voffB);
            PG8_WAIT_V(6); PG8_BAR; PG8_MMA(1, 1, At, B1); PG8_BAR;
            PG8_LDB(B0, 1, 0); PG8_SCHED; PG8_LDA(At, 1, 0); PG8_STAGE(PG8_SA(0, 1), a2 + hstep, voffA);
            PG8_WAIT_L(8); PG8_BAR; PG8_WAIT_L(0); PG8_MMA(0, 0, At, B0); PG8_BAR; PG8_SCHED;
            PG8_LDB(B1, 1, 1); PG8_STAGE(PG8_SB(1, 0), b3, voffB);
            PG8_BAR; PG8_WAIT_L(0); PG8_MMA(0, 1, At, B1); PG8_BAR;
            PG8_LDA(At, 1, 1); PG8_STAGE(PG8_SA(1, 0), a3, voffA);
            PG8_BAR; PG8_WAIT_L(0); PG8_MMA(1, 0, At, B0); PG8_BAR; PG8_SCHED;
            PG8_STAGE(PG8_SB(1, 1), b3 + hstep, voffB);
            PG8_WAIT_V(6); PG8_BAR; PG8_MMA(1, 1, At, B1); PG8_BAR;
            }
        }
        if constexpr (ALIGN_EPI) { if (wr == 0) PG8_BAR; }
        if constexpr (!Epi::AFTER_DRAIN) { E(acc, cur, wr, wc, fr, fq); S.done(cur); }
        if (!has_next) break;
#pragma unroll
        for (int a = 0; a < 2; ++a)
#pragma unroll
            for (int b = 0; b < 2; ++b)
#pragma unroll
                for (int m = 0; m < 4; ++m)
#pragma unroll
                    for (int n = 0; n < 2; ++n) acc[a][b][m][n] = (f32x4){0.f, 0.f, 0.f, 0.f};
        cur = nxt; cA = nA; cB = nB; ++ui;
        if constexpr (ALIGN_EPI) { if (wr == 1) PG8_BAR; }
    }
    PG8_WAIT_V(0);
    if constexpr (!ALIGN_EPI) { if (wr == 0) PG8_BAR; }
    PG8_BAR;
    if constexpr (Epi::AFTER_DRAIN) { E.fused(acc, cur, wr, wc, fr, fq, lds, wid, lane); S.done(cur); }
#undef PG8_SA
#undef PG8_SB
#undef PG8_STAGE
#undef PG8_LDA
#undef PG8_LDB
#undef PG8_MMA
#undef PG8_WAIT_V
#undef PG8_WAIT_L
#undef PG8_BAR
#undef PG8_SCHED
}
}
namespace att {
using bf16 = __hip_bfloat16;
constexpr int   D = 128, NW = 8, QBLK = 32, KVBLK = 64;
constexpr float SCALE = 0.088388347648318440f;
constexpr float THR = 8.f;
constexpr int SDEPTH = 2;
constexpr int LDQ = 1024, LDK = 256, LDO = 1024;
constexpr size_t SHM_V = KVBLK * D * 2, SHM_K = KVBLK * D * 2, SHM_ATTN = 2 * SHM_V + 2 * SHM_K + NW * 64 * 4;
using bf16x8 = __attribute__((ext_vector_type(8))) short;
using s16x4  = __attribute__((ext_vector_type(4))) short;
using f32x16 = __attribute__((ext_vector_type(16))) float;
using u32x4  = __attribute__((ext_vector_type(4))) unsigned;
#define KSWZ(row, colB) ((row) * 256 + ((colB) ^ (((row) & 7) << 4)))
#define SBAR() __builtin_amdgcn_sched_barrier(0)
__device__ __forceinline__ int crow(int r, int hi) { return (r & 3) + 8 * (r >> 2) + 4 * hi; }
__device__ __forceinline__ unsigned cvtpk(float lo, float hi) {
  unsigned r; asm volatile("v_cvt_pk_bf16_f32 %0, %1, %2" : "=v"(r) : "v"(lo), "v"(hi)); return r;
}
__device__ __forceinline__ bf16x8 ld8(const bf16* p) { return *reinterpret_cast<const bf16x8*>(p); }

__device__ __forceinline__ void partialSM(f32x16& p0, f32x16& p1, float& m_reg, float& mn, float& alpha) {
  constexpr float C = SCALE * 1.4426950408889634f;
  float pmax = p0[0]; for (int r = 1; r < 16; ++r) pmax = fmaxf(pmax, p0[r]); for (int r = 0; r < 16; ++r) pmax = fmaxf(pmax, p1[r]);
  { auto rr = __builtin_amdgcn_permlane32_swap(__float_as_uint(pmax), __float_as_uint(pmax), false, false);
    pmax = fmaxf(__uint_as_float(rr[0]), __uint_as_float(rr[1])); }
  if (__builtin_expect(__all(pmax - m_reg <= THR / SCALE), 1)) { mn = m_reg; alpha = 1.f; }
  else { mn = fmaxf(m_reg, pmax); alpha = __builtin_amdgcn_exp2f((m_reg - mn) * C); m_reg = mn; }
  float mnC = -mn * C;
  for (int r = 0; r < 16; ++r) p0[r] = fmaf(p0[r], C, mnC); for (int r = 0; r < 16; ++r) p1[r] = fmaf(p1[r], C, mnC);
  for (int r = 0; r < 16; ++r) p0[r] = __builtin_amdgcn_exp2f(p0[r]);
}
__device__ __forceinline__ void finishSM(f32x16& p0, f32x16& p1, float alpha, float& l_reg, bf16x8& pa0, bf16x8& pa1, bf16x8& pa2, bf16x8& pa3) {
  for (int r = 0; r < 16; ++r) p1[r] = __builtin_amdgcn_exp2f(p1[r]);
  float ps = 0; for (int r = 0; r < 16; ++r) ps += p0[r]; for (int r = 0; r < 16; ++r) ps += p1[r];
  { auto rr = __builtin_amdgcn_permlane32_swap(__float_as_uint(ps), __float_as_uint(ps), false, false);
    ps = __uint_as_float(rr[0]) + __uint_as_float(rr[1]); }
  l_reg = l_reg * alpha + ps;
#define PK4(P, BASE, OUT) do { unsigned a0 = cvtpk(P[BASE + 0], P[BASE + 1]), a1 = cvtpk(P[BASE + 2], P[BASE + 3]);   \
    unsigned b0 = cvtpk(P[BASE + 4], P[BASE + 5]), b1 = cvtpk(P[BASE + 6], P[BASE + 7]);                              \
    auto r0 = __builtin_amdgcn_permlane32_swap(a0, b0, false, false); auto r1 = __builtin_amdgcn_permlane32_swap(a1, b1, false, false); \
    u32x4 w = {r0[0], r1[0], r0[1], r1[1]}; OUT = *reinterpret_cast<bf16x8*>(&w); } while (0)
  PK4(p0, 0, pa0); PK4(p0, 8, pa1); PK4(p1, 0, pa2); PK4(p1, 8, pa3);
#undef PK4
}
__device__ __forceinline__ void qkt(f32x16& p0, f32x16& p1, const bf16* Ks, const bf16x8* qr, int r32, int hi) {
  p0 = f32x16{}; p1 = f32x16{};
  for (int d0 = 0; d0 < 8; ++d0) { int cb = (d0 * 16 + hi * 8) * 2;
    bf16x8 b0 = *reinterpret_cast<const bf16x8*>((const char*)Ks + KSWZ(r32, cb));
    bf16x8 b1 = *reinterpret_cast<const bf16x8*>((const char*)Ks + KSWZ(32 + r32, cb));
    p0 = __builtin_amdgcn_mfma_f32_32x32x16_bf16(b0, qr[d0], p0, 0, 0, 0);
    p1 = __builtin_amdgcn_mfma_f32_32x32x16_bf16(b1, qr[d0], p1, 0, 0, 0); }
}
__device__ __forceinline__ int v_st(int k, int c) { const int kk = (k & ~0xC) | ((k & 4) << 1) | ((k & 8) >> 1); return ((kk >> 3) * 4 + (c >> 5)) * 512 + ((kk & 7) * 32 + (c & 31)) * 2; }
__device__ __forceinline__ int v_rd_base(int lane) { return ((lane & 3) << 3) | (((lane >> 2) & 3) << 6) | (((lane >> 4) & 1) << 5) | (((lane >> 5) & 1) << 8); }
constexpr int v_rd_off(int d0, int ks, int half) { return d0 * 512 + ks * 4096 + half * 2048; }
template <int OFF> __device__ __forceinline__ s16x4 tr_read(int vb) {
  s16x4 r; asm volatile("ds_read_b64_tr_b16 %0, %1 offset:%2" : "=&v"(r) : "v"(vb), "i"(OFF) : "memory"); return r;
}
template <int D0> __device__ __forceinline__ void pv_one(f32x16& od, int vb, bf16x8 pa0, bf16x8 pa1, bf16x8 pa2, bf16x8 pa3) {
  const s16x4 l0 = tr_read<v_rd_off(D0, 0, 0)>(vb), h0 = tr_read<v_rd_off(D0, 0, 1)>(vb), l1 = tr_read<v_rd_off(D0, 1, 0)>(vb), h1 = tr_read<v_rd_off(D0, 1, 1)>(vb);
  const s16x4 l2 = tr_read<v_rd_off(D0, 2, 0)>(vb), h2 = tr_read<v_rd_off(D0, 2, 1)>(vb), l3 = tr_read<v_rd_off(D0, 3, 0)>(vb), h3 = tr_read<v_rd_off(D0, 3, 1)>(vb);
  asm volatile("s_waitcnt lgkmcnt(0)" ::: "memory"); SBAR();
#define PK(L, H) (bf16x8){L[0], L[1], L[2], L[3], H[0], H[1], H[2], H[3]}
  od = __builtin_amdgcn_mfma_f32_32x32x16_bf16(pa0, PK(l0, h0), od, 0, 0, 0);
  od = __builtin_amdgcn_mfma_f32_32x32x16_bf16(pa1, PK(l1, h1), od, 0, 0, 0);
  od = __builtin_amdgcn_mfma_f32_32x32x16_bf16(pa2, PK(l2, h2), od, 0, 0, 0);
  od = __builtin_amdgcn_mfma_f32_32x32x16_bf16(pa3, PK(l3, h3), od, 0, 0, 0);
#undef PK
}
__device__ __forceinline__ void pv_d0(f32x16* o, int vb, bf16x8 pa0, bf16x8 pa1, bf16x8 pa2, bf16x8 pa3) {
  pv_one<0>(o[0], vb, pa0, pa1, pa2, pa3); pv_one<1>(o[1], vb, pa0, pa1, pa2, pa3); pv_one<2>(o[2], vb, pa0, pa1, pa2, pa3); pv_one<3>(o[3], vb, pa0, pa1, pa2, pa3);
}
__device__ __forceinline__ void attn_dense_body(const bf16* __restrict__ Qb, const bf16* __restrict__ Kh, const bf16* __restrict__ Vh,
                                                bf16* __restrict__ Ob, int seq, char* lds) {
  const int tid = threadIdx.x, wid = tid >> 6, lane = tid & 63, r32 = lane & 31, hi = lane >> 5;
  bf16* V_lds = (bf16*)lds; bf16* K_lds = (bf16*)(lds + 2 * SHM_V);
  float* ws = (float*)(lds + 2 * SHM_V + 2 * SHM_K) + wid * 64; float* li_l = ws; float* al_l = ws + 32;
  float m_reg = -1e30f, l_reg = 0; f32x16 o[4] = {}; bf16x8 qr[8];
  const bf16* Qw = Qb + (long)(wid * QBLK + r32) * LDQ + hi * 8;
#pragma unroll
  for (int d0 = 0; d0 < 8; ++d0) qr[d0] = ld8(Qw + d0 * 16);
  const int sr = tid >> 4, sc = (tid & 15) * 8, vst0 = v_st(sr, sc), vst1 = v_st(32 + sr, sc);
  const int vb0 = (int)(uintptr_t)V_lds + v_rd_base(lane);
  struct { bf16x8 vs0, vs1, ks0, ks1; } sr_[SDEPTH];
#define SLOAD(i, k0) do { sr_[i].vs0 = ld8(&Vh[(long)((k0) + sr) * LDK + sc]); sr_[i].vs1 = ld8(&Vh[(long)((k0) + 32 + sr) * LDK + sc]); \
    sr_[i].ks0 = ld8(&Kh[(long)((k0) + sr) * LDK + sc]); sr_[i].ks1 = ld8(&Kh[(long)((k0) + 32 + sr) * LDK + sc]); } while (0)
#define SWRITE(b, i) do { *(bf16x8*)((char*)V_lds + (b) * SHM_V + vst0) = sr_[i].vs0;          \
    *(bf16x8*)((char*)V_lds + (b) * SHM_V + vst1) = sr_[i].vs1; int kc = sc * 2;               \
    *(bf16x8*)((char*)K_lds + (b) * SHM_K + KSWZ(sr, kc)) = sr_[i].ks0;                       \
    *(bf16x8*)((char*)K_lds + (b) * SHM_K + KSWZ(32 + sr, kc)) = sr_[i].ks1; } while (0)
#define SWAIT() do { if constexpr (SDEPTH == 2) asm volatile("s_waitcnt vmcnt(4)" ::: "memory"); else asm volatile("s_waitcnt vmcnt(0)" ::: "memory"); } while (0)
#define RESC(a) do { if (__any((a) < 1.f)) { if (hi == 0) al_l[r32] = (a); asm volatile("s_waitcnt lgkmcnt(0)" ::: "memory"); \
    for (int d = 0; d < 4; ++d) for (int r = 0; r < 16; ++r) o[d][r] *= al_l[crow(r, hi)]; } } while (0)
  f32x16 pA0, pA1, pB0, pB1; float mnA, mnB, alA, alB; bf16x8 pa0, pa1, pa2, pa3; const int NT = seq / KVBLK;
  constexpr int SE = 0, SO = SDEPTH - 1;
  SLOAD(SE, 0); asm volatile("s_waitcnt vmcnt(0)" ::: "memory"); SWRITE(0, SE); __syncthreads();
  qkt(pA0, pA1, K_lds, qr, r32, hi); partialSM(pA0, pA1, m_reg, mnA, alA);
  SLOAD(SO, KVBLK); if constexpr (SDEPTH == 2) { if (2 < NT) SLOAD(SE, 2 * KVBLK); }
  SWAIT(); SWRITE(1, SO); __syncthreads();
  for (int j = 1; j + 1 < NT; j += 2) {
    SBAR(); qkt(pB0, pB1, (bf16*)((char*)K_lds + SHM_K), qr, r32, hi);
    finishSM(pA0, pA1, alA, l_reg, pa0, pa1, pa2, pa3); SBAR();
    SLOAD(SO, (j + SDEPTH) * KVBLK); SBAR();
    pv_d0(o, vb0, pa0, pa1, pa2, pa3); partialSM(pB0, pB1, m_reg, mnB, alB);
    __syncthreads(); SWAIT(); SWRITE(0, SE);
    RESC(alB); __syncthreads();
    SBAR(); qkt(pA0, pA1, K_lds, qr, r32, hi);
    finishSM(pB0, pB1, alB, l_reg, pa0, pa1, pa2, pa3); SBAR();
    if (SDEPTH == 1 || j + 3 < NT) SLOAD(SE, (j + 1 + SDEPTH) * KVBLK); SBAR();
    pv_d0(o, vb0 + (int)SHM_V, pa0, pa1, pa2, pa3); partialSM(pA0, pA1, m_reg, mnA, alA);
    __syncthreads(); SWAIT(); SWRITE(1, SO);
    RESC(alA); __syncthreads();
  }
  SBAR(); qkt(pB0, pB1, (bf16*)((char*)K_lds + SHM_K), qr, r32, hi);
  finishSM(pA0, pA1, alA, l_reg, pa0, pa1, pa2, pa3); SBAR();
  pv_d0(o, vb0, pa0, pa1, pa2, pa3); partialSM(pB0, pB1, m_reg, mnB, alB);
  __syncthreads(); RESC(alB);
  finishSM(pB0, pB1, alB, l_reg, pa0, pa1, pa2, pa3); SBAR();
  pv_d0(o, vb0 + (int)SHM_V, pa0, pa1, pa2, pa3);
  if (hi == 0) li_l[r32] = l_reg; asm volatile("s_waitcnt lgkmcnt(0)" ::: "memory");
  float rli[16];
#pragma unroll
  for (int r = 0; r < 16; ++r) rli[r] = __builtin_amdgcn_rcpf(li_l[crow(r, hi)]);
  bf16* Ow = Ob + (long)(wid * QBLK) * LDO;
#pragma unroll
  for (int r = 0; r < 16; ++r) { int orow = crow(r, hi);
    for (int d0 = 0; d0 < 4; ++d0) Ow[(long)orow * LDO + d0 * 32 + r32] = __float2bfloat16(o[d0][r] * rli[r]); }
  __syncthreads();
#undef SLOAD
#undef SWRITE
#undef SWAIT
#undef RESC
}
#undef KSWZ
#undef SBAR
}

constexpr int NWAVES = 8;
constexpr int DM = 1024, NTOK = 6144, NPTOK = 4096, TP = 256, TS = 1024, FF = 2816, NGU = 5632, NQKV = 1536, PAST = 512, SKV_S = PAST + TS;
constexpr float EPS = 1e-6f;
enum { I_XP = 0, I_XS, I_C, I_STATE, I_CK, I_CV, I_CCTX, I_MODW, I_MODB, I_NORMG, I_WGU, I_WDN, I_LIN, I_CONVW, I_CONVB, I_GATEW, I_GATEB, I_LAM, I_LOUT, I_WQKV, I_QG, I_KG, I_WO, I_FING, N_IN };
constexpr size_t OUT_Y = 0, OUT_STATE = (size_t)NTOK * DM, OUT_CK = OUT_STATE + 16 * 2 * DM, OUT_CV = OUT_CK + (size_t)NPTOK * 256, OUT_END = OUT_CV + (size_t)NPTOK * 256;
constexpr size_t MiB = 1u << 20;
constexpr size_t WS_CTL = 0, CTL_ZERO_BYTES = 1 * MiB;
constexpr size_t WS_MOD = 1 * MiB;
constexpr size_t WS_WGU = 2 * MiB;
constexpr size_t WS_WDN = WS_WGU + (size_t)4 * NGU * DM * 2;
constexpr size_t WS_WIN = WS_WDN + (size_t)4 * DM * FF * 2;
constexpr size_t WS_WOUT = WS_WIN + (size_t)2048 * DM * 2;
constexpr size_t WS_WQKV = WS_WOUT + (size_t)DM * DM * 2;
constexpr size_t WS_WO = WS_WQKV + (size_t)NQKV * DM * 2;
constexpr size_t WS_GT = WS_WO + (size_t)DM * DM * 2;
constexpr size_t WS_X = 80 * MiB;
constexpr size_t WS_H = 104 * MiB;
constexpr size_t WS_ACT = 116 * MiB;
constexpr size_t WS_P = 150 * MiB;
constexpr size_t WS_AU = 198 * MiB;
constexpr size_t WS_END = 294 * MiB;
static_assert(WS_GT + 4 * 16 * 64 * 64 * 2 <= WS_X, "weights fit below X");
constexpr size_t AT_QKV = WS_AU;
constexpr size_t AT_QB = WS_AU + 36 * MiB;
constexpr size_t AT_KP = WS_AU + 48 * MiB;
constexpr size_t AT_VP = WS_AU + 50 * MiB;
constexpr size_t AT_KS = WS_AU + 52 * MiB;
constexpr size_t AT_VS = WS_AU + 54 * MiB;
constexpr int CW_BAR = 4096;
constexpr int RING_BYTES = 131072, LDSCTL_OFF = RING_BYTES, MISC_OFF = LDSCTL_OFF + 320, LDS_BYTES = 147456;

#define GAS __attribute__((address_space(1)))
#define LAS __attribute__((address_space(3)))
typedef unsigned short bf16;
typedef unsigned v4u __attribute__((ext_vector_type(4)));
typedef float f32x4 __attribute__((ext_vector_type(4)));
typedef short bf16x8 __attribute__((ext_vector_type(8)));
typedef GAS unsigned gu32;
typedef GAS unsigned long long gu64;
#define RLX_AGENT __ATOMIC_RELAXED, __HIP_MEMORY_SCOPE_AGENT
#define LDS_WAIT() asm volatile("s_waitcnt lgkmcnt(0)" ::: "memory")
#define VM_WAIT() asm volatile("s_waitcnt vmcnt(0)" ::: "memory")
__device__ __forceinline__ unsigned long long rt() { return __builtin_amdgcn_s_memrealtime(); }
__device__ __forceinline__ unsigned f2bf(float f) { unsigned u = __builtin_bit_cast(unsigned, f); return (u + 0x7fffu + ((u >> 16) & 1u)) >> 16; }
__device__ __forceinline__ unsigned pk2(float lo, float hi) { return f2bf(lo) | (f2bf(hi) << 16); }

#define XB_TMO      128
#define XB_XCNT(j)  (256  + 64 * (j))
#define XB_XSUB(j)  (1280 + 64 * (j))
#define XB_XGEN(j)  (2304 + 64 * (j))
#define XB_TOP      3328
#define XB_TOPGEN   3392
#define XCD_BAR_WORDS 3456
#define XB_SPIN_CAP (1u << 18)

__device__ __forceinline__ unsigned xb_ld(unsigned* p)              { return __hip_atomic_load(p, __ATOMIC_RELAXED, __HIP_MEMORY_SCOPE_AGENT); }
__device__ __forceinline__ unsigned xb_add(unsigned* p, unsigned v) { return __hip_atomic_fetch_add(p, v, __ATOMIC_RELAXED, __HIP_MEMORY_SCOPE_AGENT); }
__device__ __forceinline__ unsigned xb_xcc_id() { return (unsigned)__builtin_amdgcn_s_getreg((3 << 11) | 20) & 0xFu; }
#define XB_SPIN(cond, bar) do { unsigned _sp = 0; while (cond) { __builtin_amdgcn_s_sleep(1); \
    if ((++_sp & 255u) == 0u) { if (xb_ld(&(bar)[XB_TMO])) break; if (_sp > XB_SPIN_CAP) { atomicAdd(&(bar)[XB_TMO], 1u); break; } } } } while (0)

struct XcdBarrier {
    unsigned* bar; unsigned x;
    volatile LAS unsigned* st;
};

__device__ __forceinline__ XcdBarrier xcd_barrier_post(unsigned* bar, volatile LAS unsigned* st) {
    XcdBarrier b; b.bar = bar; b.x = xb_xcc_id(); b.st = st;
    if (threadIdx.x == 0) (void)xb_add(&bar[XB_XCNT(b.x)], 1u);
    return b;
}
__device__ __forceinline__ void xcd_barrier_complete(unsigned* bar, unsigned x, unsigned& nloc, unsigned& nx) {
    const unsigned G = gridDim.x * gridDim.y * gridDim.z;
    unsigned sum, cnt, mine, sp = 0u;
    for (;;) {
        sum = 0u; cnt = 0u; mine = 0u;
#pragma unroll
        for (unsigned j = 0; j < 16; ++j) { const unsigned c = xb_ld(&bar[XB_XCNT(j)]); sum += c; cnt += (c > 0u) ? 1u : 0u; mine = (j == x) ? c : mine; }
        if (sum == G) break;
        __builtin_amdgcn_s_sleep(1);
        if ((++sp & 255u) == 0u) { if (xb_ld(&bar[XB_TMO])) break; if (sp > XB_SPIN_CAP) { atomicAdd(&bar[XB_TMO], 1u); break; } }
    }
    nloc = mine > 0u ? mine : 1u; nx = cnt > 0u ? cnt : 1u;
}

__device__ __forceinline__ void xcd_barrier(const XcdBarrier& b) {
    asm volatile("s_waitcnt vmcnt(0)" ::: "memory");
    __syncthreads();
    if (threadIdx.x == 0) {
        unsigned* bar = b.bar;
        __builtin_amdgcn_s_waitcnt(0);
        unsigned nloc = b.st[0], nx = b.st[1];
        if (nloc == 0u) { xcd_barrier_complete(bar, b.x, nloc, nx); b.st[0] = nloc; b.st[1] = nx; }
        const unsigned old = xb_add(&bar[XB_XSUB(b.x)], 1u);
        const unsigned gen = old / nloc;
        if (old + 1u == (gen + 1u) * nloc) {
            __builtin_amdgcn_fence(__ATOMIC_RELEASE, "agent");
            asm volatile("s_waitcnt vmcnt(0)" ::: "memory");
            const unsigned og = xb_add(&bar[XB_TOP], 1u);
            const unsigned tg = og / nx;
            if (og + 1u == (tg + 1u) * nx) xb_add(&bar[XB_TOPGEN], 1u);
            else XB_SPIN(xb_ld(&bar[XB_TOPGEN]) == tg, bar);
            __builtin_amdgcn_fence(__ATOMIC_ACQUIRE, "agent");
            xb_add(&bar[XB_XGEN(b.x)], 1u);
            asm volatile("s_waitcnt vmcnt(0)" ::: "memory");
        } else {
            XB_SPIN(xb_ld(&bar[XB_XGEN(b.x)]) == gen, bar);
            __builtin_amdgcn_fence(__ATOMIC_ACQUIRE, "agent");
            asm volatile("s_waitcnt vmcnt(0)" ::: "memory");
        }
    }
    __syncthreads();
}


typedef float f32x16 __attribute__((ext_vector_type(16)));
__device__ __forceinline__ float bf2f(unsigned short h) { return __uint_as_float((unsigned)h << 16); }
__device__ __forceinline__ float wave_sum(float v) {
#pragma unroll
    for (int o = 1; o < 64; o <<= 1) v += __shfl_xor(v, o);
    return v;
}
struct Args { const float* in[N_IN]; float* out; unsigned char* ws; int ph_lo, ph_hi; };

__device__ __forceinline__ void p0_mod(const Args& a, LAS unsigned char* lds, float* MOD, int tid, int lane, int wave) {
    LAS float* sv = (LAS float*)lds;
    LAS float* red = (LAS float*)(lds + 16384);
    const float* c_ctx = a.in[I_CCTX]; const float* cs = a.in[I_C];
    for (int i = tid; i < 3072; i += 512) { const int v = i >> 10, k = i & 1023; const float c = (v == 0) ? c_ctx[k] : cs[(v - 1) * 1024 + k]; sv[i] = c / (1.f + expf(-c)); }
    __syncthreads();
    const float* mod_w = a.in[I_MODW]; const float* mod_b = a.in[I_MODB];
    const int cg = lane & 15, kr = lane >> 4;
    for (int item = blockIdx.x; item < 288; item += gridDim.x) {
        const int l = item / 144, cb = item % 144;
        const float* W = mod_w + (size_t)l * 1024 * 9216 + cb * 64 + cg * 4;
        f32x4 a0 = {0.f, 0.f, 0.f, 0.f}, a1 = a0, a2 = a0;
        const int kbase = wave * 128 + kr;
#pragma unroll 8
        for (int kk = 0; kk < 32; ++kk) { const int k = kbase + 4 * kk; const f32x4 w = *(const f32x4*)(W + (size_t)k * 9216); a0 += sv[k] * w; a1 += sv[1024 + k] * w; a2 += sv[2048 + k] * w; }
#pragma unroll
        for (int j = 0; j < 4; ++j) { a0[j] += __shfl_xor(a0[j], 16); a0[j] += __shfl_xor(a0[j], 32); a1[j] += __shfl_xor(a1[j], 16); a1[j] += __shfl_xor(a1[j], 32); a2[j] += __shfl_xor(a2[j], 16); a2[j] += __shfl_xor(a2[j], 32); }
        if (kr == 0) {
#pragma unroll
            for (int j = 0; j < 4; ++j) { red[(wave * 3 + 0) * 64 + cg * 4 + j] = a0[j]; red[(wave * 3 + 1) * 64 + cg * 4 + j] = a1[j]; red[(wave * 3 + 2) * 64 + cg * 4 + j] = a2[j]; } }
        __syncthreads();
        if (tid < 192) { const int v = tid >> 6, c = tid & 63; float s = mod_b[l * 9216 + cb * 64 + c];
#pragma unroll
            for (int w = 0; w < 8; ++w) s += red[(w * 3 + v) * 64 + c];
            MOD[(l * 3 + v) * 9216 + cb * 64 + c] = s; }
        __syncthreads();
    }
}
__device__ __forceinline__ void tr_item(const float* W, int K, int N, bf16* WT, int drow, int k0, int n0, LAS float* scr, int lane) {
#pragma unroll 8
    for (int i = 0; i < 32; ++i) { const int kk = 2 * i + (lane >> 5); scr[kk * 33 + (lane & 31)] = W[(size_t)(k0 + kk) * N + n0 + (lane & 31)]; }
    LDS_WAIT(); asm volatile("" ::: "memory");
    const int c = lane & 7;
#pragma unroll
    for (int j = 0; j < 4; ++j) { const int n = (lane >> 3) + 8 * j; const LAS float* s = scr + (8 * c) * 33 + n;
        v4u o; o.x = pk2(s[0 * 33], s[1 * 33]); o.y = pk2(s[2 * 33], s[3 * 33]); o.z = pk2(s[4 * 33], s[5 * 33]); o.w = pk2(s[6 * 33], s[7 * 33]);
        *(GAS v4u*)(WT + (size_t)(drow + n) * K + k0 + 8 * c) = o; }
    LDS_WAIT(); asm volatile("" ::: "memory");
}
__device__ __forceinline__ void p0_weights(const Args& a, LAS unsigned char* lds, int gw, int NGW, int wave, int lane) {
    LAS float* scr = (LAS float*)(lds + wave * 16384);
    unsigned char* ws = a.ws;
    constexpr int IGU = 16 * 176, IDN = 44 * 32, IIN = 16 * 64, IOUT = 16 * 32, IQKV = 16 * 48, IO = 16 * 32, IG = 128;
    constexpr int NITEMS = 4 * IGU + 4 * IDN + IIN + IOUT + IQKV + IO + IG;
    for (int it = gw; it < NITEMS; it += NGW) {
        int r = it;
        if (r < 4 * IGU) { const int m = r / IGU, q = r % IGU, kb = q / 176, nb = q % 176, n0 = nb * 32;
            const int drow = (n0 < FF) ? 256 * (n0 / 128) + (n0 % 128) : 256 * ((n0 - FF) / 128) + 128 + ((n0 - FF) % 128);
            tr_item(a.in[I_WGU] + (size_t)m * DM * NGU, DM, NGU, (bf16*)(ws + WS_WGU) + (size_t)m * NGU * DM, drow, kb * 64, n0, scr, lane); continue; } r -= 4 * IGU;
        if (r < 4 * IDN) { const int m = r / IDN, q = r % IDN, kb = q / 32, nb = q % 32;
            tr_item(a.in[I_WDN] + (size_t)m * FF * DM, FF, DM, (bf16*)(ws + WS_WDN) + (size_t)m * DM * FF, nb * 32, kb * 64, nb * 32, scr, lane); continue; } r -= 4 * IDN;
        if (r < IIN) { const int kb = r / 64, nb = r % 64; tr_item(a.in[I_LIN], DM, 2048, (bf16*)(ws + WS_WIN), nb * 32, kb * 64, nb * 32, scr, lane); continue; } r -= IIN;
        if (r < IOUT) { const int kb = r / 32, nb = r % 32; tr_item(a.in[I_LOUT], DM, DM, (bf16*)(ws + WS_WOUT), nb * 32, kb * 64, nb * 32, scr, lane); continue; } r -= IOUT;
        if (r < IQKV) { const int kb = r / 48, nb = r % 48; tr_item(a.in[I_WQKV], DM, NQKV, (bf16*)(ws + WS_WQKV), nb * 32, kb * 64, nb * 32, scr, lane); continue; } r -= IQKV;
        if (r < IO) { const int kb = r / 32, nb = r % 32; tr_item(a.in[I_WO], DM, DM, (bf16*)(ws + WS_WO), nb * 32, kb * 64, nb * 32, scr, lane); continue; } r -= IO;
        { const int mat = r >> 1, nb = r & 1; tr_item(a.in[I_GATEW] + (size_t)mat * 4096, 64, 64, (bf16*)(ws + WS_GT) + (size_t)mat * 4096, nb * 32, 0, nb * 32, scr, lane); }
    }
}

template <int MODE>
__device__ __forceinline__ void norm_phase(const Args& a, int gw, int NGW, int lane, int lg, int sg, float coef, int ln, int sn) {
    unsigned char* ws = a.ws;
    float* X = (float*)(ws + WS_X); const float* P0 = (const float*)(ws + WS_P); const float* P1 = P0 + (size_t)NTOK * DM; const float* MOD = (const float*)(ws + WS_MOD);
    bf16* H = (bf16*)(ws + WS_H);
    for (int row = gw; row < NTOK; row += NGW) {
        const int v = row < NPTOK ? 0 : 1 + ((row - NPTOK) >> 10);
        f32x4 x[4]; float ss = 0.f;
#pragma unroll
        for (int j = 0; j < 4; ++j) { const int c = 4 * lane + 256 * j;
            if (MODE == 0) { x[j] = row < NPTOK ? *(const f32x4*)(a.in[I_XP] + (size_t)row * DM + c) : *(const f32x4*)(a.in[I_XS] + (size_t)(row - NPTOK) * DM + c); }
            else { const f32x4 xo = *(const GAS f32x4*)(X + (size_t)row * DM + c); const f32x4 p = *(const GAS f32x4*)(P0 + (size_t)row * DM + c) + *(const GAS f32x4*)(P1 + (size_t)row * DM + c);
                   const f32x4 gt = *(const GAS f32x4*)(MOD + (size_t)(lg * 3 + v) * 9216 + sg * 3072 + 2048 + c); x[j] = xo + coef * gt * p; }
            ss += (x[j].x * x[j].x + x[j].y * x[j].y) + (x[j].z * x[j].z + x[j].w * x[j].w); }
        const float rstd = 1.0f / sqrtf(wave_sum(ss) * (1.f / DM) + EPS);
#pragma unroll
        for (int j = 0; j < 4; ++j) { const int c = 4 * lane + 256 * j;
            if (MODE == 2) { const f32x4 g = *(const f32x4*)(a.in[I_FING] + c); *(GAS f32x4*)(a.out + OUT_Y + (size_t)row * DM + c) = x[j] * rstd * g; }
            else { *(GAS f32x4*)(X + (size_t)row * DM + c) = x[j];
                   const f32x4 g = *(const f32x4*)(a.in[I_NORMG] + (size_t)(ln * 3 + sn) * DM + c);
                   const f32x4 sh = *(const GAS f32x4*)(MOD + (size_t)(ln * 3 + v) * 9216 + sn * 3072 + c), sc = *(const GAS f32x4*)(MOD + (size_t)(ln * 3 + v) * 9216 + sn * 3072 + 1024 + c);
                   const f32x4 h = (x[j] * rstd) * g * (1.0f + sc) + sh;
                   *(GAS unsigned long long*)(H + (size_t)row * DM + c) = (unsigned long long)pk2(h.x, h.y) | ((unsigned long long)pk2(h.z, h.w) << 32); } }
    }
}

__device__ __forceinline__ float gelu_tanh(float x) { const float z = 0.7978845608028654f * (x + 0.044715f * x * x * x); return x * __builtin_amdgcn_rcpf(1.0f + __builtin_amdgcn_exp2f(-2.0f * 1.4426950408889634f * z)); }
__device__ __forceinline__ float fsigmoid(float x) { return __builtin_amdgcn_rcpf(1.0f + __builtin_amdgcn_exp2f(-1.4426950408889634f * x)); }
__device__ __forceinline__ void swap32(float x, float& lo, float& hh) {
    auto rr = __builtin_amdgcn_permlane32_swap(__float_as_uint(x), __float_as_uint(x), false, false); lo = __uint_as_float(rr[0]); hh = __uint_as_float(rr[1]); }
template <int PASS>
__device__ __forceinline__ void lru_pass(const Args& a, LAS unsigned char* lds, int gw, int NGW, int wave, int lane) {
    unsigned char* ws = a.ws;
    const bf16* XY = (const bf16*)(ws + WS_ACT); const bf16* GT = (const bf16*)(ws + WS_GT); float* SUMM = (float*)(ws + WS_AU); bf16* Y = (bf16*)(ws + WS_H);
    LAS float* xcs = (LAS float*)(lds + wave * 8704);
    const int r32 = lane & 31, hi = lane >> 5;
    for (int task = gw; task < 192 * 16; task += NGW) {
        const int n = task / 192, tc = task % 192, r0 = tc * 32;
        const bool smp = r0 >= NPTOK;
        const int s0 = !smp ? (r0 & ~(TP - 1)) : NPTOK + ((r0 - NPTOK) & ~(TS - 1)), T = !smp ? TP : TS;
        const int c0 = s0 >> 5, nc = T >> 5, bsq = smp ? (s0 - NPTOK) / TS : s0 / TP;
        { const int col = n * 64 + lane;
          const float w0 = a.in[I_CONVW][0 * DM + col], w1 = a.in[I_CONVW][1 * DM + col], w2 = a.in[I_CONVW][2 * DM + col], w3 = a.in[I_CONVW][3 * DM + col], cb = a.in[I_CONVB][col];
          float xv[35];
#pragma unroll
          for (int i = 0; i < 35; ++i) { const int t = r0 - 1 + i; const bool ok = (t >= s0) && (t < s0 + T); const int tt = ok ? t : r0;
              const float val = bf2f(*(const GAS unsigned short*)(XY + (size_t)tt * 2048 + col)); xv[i] = ok ? val : 0.f; }
#pragma unroll
          for (int j = 0; j < 32; ++j) xcs[j * 68 + lane] = cb + w0 * xv[j] + w1 * xv[j + 1] + w2 * xv[j + 2] + w3 * xv[j + 3];
        }
        LDS_WAIT(); asm volatile("" ::: "memory");
        pg8::bf16x8 af[4];
#pragma unroll
        for (int s = 0; s < 4; ++s) { const LAS f32x4* p = (const LAS f32x4*)(xcs + r32 * 68 + 16 * s + 8 * hi); const f32x4 lo = p[0], hh = p[1];
            v4u w; w.x = pk2(lo.x, lo.y); w.y = pk2(lo.z, lo.w); w.z = pk2(hh.x, hh.y); w.w = pk2(hh.z, hh.w); af[s] = __builtin_bit_cast(pg8::bf16x8, w); }
        float hin[2][2] = {{0.f, 0.f}, {0.f, 0.f}};
        if (PASS == 2) {
            const int chA = n * 64 + r32, chB = chA + 32;
            float hA = smp ? a.in[I_STATE][(bsq * 2 + 0) * DM + chA] : 0.f, hB = smp ? a.in[I_STATE][(bsq * 2 + 0) * DM + chB] : 0.f;
            for (int cbs = c0; cbs < tc; cbs += 8) { float A0[8], H0[8], A1[8], H1[8];
#pragma unroll
                for (int i = 0; i < 8; ++i) { const int c = cbs + i; const bool ok = c < tc; const int cc = ok ? c : c0; const GAS float* q = (const GAS float*)SUMM + (size_t)(cc * 2 + 0) * 2 * DM;
                    const float ta = q[chA], th = q[DM + chA], tb = q[chB], tg = q[DM + chB]; A0[i] = ok ? ta : 1.f; H0[i] = ok ? th : 0.f; A1[i] = ok ? tb : 1.f; H1[i] = ok ? tg : 0.f; }
#pragma unroll
                for (int i = 0; i < 8; ++i) { hA = A0[i] * hA + H0[i]; hB = A1[i] * hB + H1[i]; } }
            hin[0][0] = hA; hin[1][0] = hB;
            hA = smp ? a.in[I_STATE][(bsq * 2 + 1) * DM + chA] : 0.f; hB = smp ? a.in[I_STATE][(bsq * 2 + 1) * DM + chB] : 0.f;
            for (int cbs = c0 + nc - 1; cbs > tc; cbs -= 8) { float A0[8], H0[8], A1[8], H1[8];
#pragma unroll
                for (int i = 0; i < 8; ++i) { const int c = cbs - i; const bool ok = c > tc; const int cc = ok ? c : c0; const GAS float* q = (const GAS float*)SUMM + (size_t)(cc * 2 + 1) * 2 * DM;
                    const float ta = q[chA], th = q[DM + chA], tb = q[chB], tg = q[DM + chB]; A0[i] = ok ? ta : 1.f; H0[i] = ok ? th : 0.f; A1[i] = ok ? tb : 1.f; H1[i] = ok ? tg : 0.f; }
#pragma unroll
                for (int i = 0; i < 8; ++i) { hA = A0[i] * hA + H0[i]; hB = A1[i] * hB + H1[i]; } }
            hin[0][1] = hA; hin[1][1] = hB;
        }
#pragma unroll
        for (int ct = 0; ct < 2; ++ct) { const int ch = n * 64 + ct * 32 + r32;
            float xcv[16], hfw[16];
#pragma unroll
            for (int r = 0; r < 16; ++r) xcv[r] = xcs[((r & 3) + 8 * (r >> 2) + 4 * hi) * 68 + ct * 32 + r32];
#pragma unroll
            for (int d = 0; d < 2; ++d) {
                f32x16 cr = {}, ci = {};
#pragma unroll
                for (int s = 0; s < 4; ++s) {
                    const pg8::bf16x8 br = *(const GAS pg8::bf16x8*)(GT + ((size_t)((2 * d + 0) * 16 + n) * 64 + ct * 32 + r32) * 64 + 16 * s + 8 * hi);
                    const pg8::bf16x8 bi = *(const GAS pg8::bf16x8*)(GT + ((size_t)((2 * d + 1) * 16 + n) * 64 + ct * 32 + r32) * 64 + 16 * s + 8 * hi);
                    cr = __builtin_amdgcn_mfma_f32_32x32x16_bf16(af[s], br, cr, 0, 0, 0); ci = __builtin_amdgcn_mfma_f32_32x32x16_bf16(af[s], bi, ci, 0, 0, 0); }
                const float gbr = a.in[I_GATEB][(d * 2 + 0) * DM + ch], gbi = a.in[I_GATEB][(d * 2 + 1) * DM + ch];
                const float lam = a.in[I_LAM][d * DM + ch]; const float ls8 = -8.0f * log1pf(expf(-lam));
                float A[16], U[16];
#pragma unroll
                for (int r = 0; r < 16; ++r) { const float rg = fsigmoid(cr[r] + gbr), ig = fsigmoid(ci[r] + gbi); const float la = ls8 * rg;
                    const float av = __builtin_amdgcn_exp2f(1.4426950408889634f * la); const float x2 = 2.0f * la;
                    const float ser = -x2 * (1.0f + x2 * (0.5f + x2 * (0.16666667f + x2 * (0.041666668f + x2 * 0.0083333333f))));
                    const float m2 = (x2 > -0.25f) ? ser : fmaxf(1.0f - av * av, 0.f);
                    A[r] = av; U[r] = __builtin_amdgcn_sqrtf(m2) * (ig * xcv[r]); }
                float cin[4], lo, hh, c = (PASS == 2) ? hin[ct][d] : 0.f;
                if (d == 0) {
#pragma unroll
                    for (int g = 0; g < 4; ++g)
#pragma unroll
                        for (int i = 1; i < 4; ++i) { U[4 * g + i] = A[4 * g + i] * U[4 * g + i - 1] + U[4 * g + i]; A[4 * g + i] *= A[4 * g + i - 1]; }
#pragma unroll
                    for (int g = 0; g < 4; ++g) { const float GA = A[4 * g + 3], GH = U[4 * g + 3];
                        float co = GA * c + GH; swap32(co, lo, hh); c = hi ? lo : c; cin[g] = c;
                        co = GA * c + GH; swap32(co, lo, hh); c = hi ? c : hh; }
                    if (PASS == 1) { const float pl = (A[3] * A[7]) * (A[11] * A[15]); float pa, pb; swap32(pl, pa, pb);
                        if (hi == 0) { GAS float* q = (GAS float*)SUMM + (size_t)(tc * 2 + 0) * 2 * DM; q[ch] = pa * pb; q[DM + ch] = hh; } }
                    else {
#pragma unroll
                        for (int r = 0; r < 16; ++r) hfw[r] = U[r] + A[r] * cin[r >> 2];
                        if (!smp && tc == c0 + nc - 1 && hi == 1) a.out[OUT_STATE + (size_t)(bsq * 2 + 0) * DM + ch] = hfw[15]; }
                } else {
#pragma unroll
                    for (int g = 0; g < 4; ++g)
#pragma unroll
                        for (int i = 2; i >= 0; --i) { U[4 * g + i] = A[4 * g + i] * U[4 * g + i + 1] + U[4 * g + i]; A[4 * g + i] *= A[4 * g + i + 1]; }
#pragma unroll
                    for (int g = 3; g >= 0; --g) { const float GA = A[4 * g], GH = U[4 * g];
                        float co = GA * c + GH; swap32(co, lo, hh); c = hi ? c : hh; cin[g] = c;
                        co = GA * c + GH; swap32(co, lo, hh); c = hi ? lo : c; }
                    if (PASS == 1) { const float pl = (A[0] * A[4]) * (A[8] * A[12]); float pa, pb; swap32(pl, pa, pb);
                        if (hi == 0) { GAS float* q = (GAS float*)SUMM + (size_t)(tc * 2 + 1) * 2 * DM; q[ch] = pa * pb; q[DM + ch] = lo; } }
                    else {
                        if (!smp && tc == c0 && hi == 0) a.out[OUT_STATE + (size_t)(bsq * 2 + 1) * DM + ch] = U[0] + A[0] * cin[0];
#pragma unroll
                        for (int r = 0; r < 16; ++r) { const size_t row = (size_t)(r0 + (r & 3) + 8 * (r >> 2) + 4 * hi);
                            const float hb = U[r] + A[r] * cin[r >> 2]; const float yb = bf2f(*(const GAS unsigned short*)(XY + row * 2048 + 1024 + ch));
                            *(GAS unsigned short*)(Y + row * DM + ch) = (unsigned short)f2bf((hfw[r] + hb) * gelu_tanh(yb)); } }
                }
            }
        }
        LDS_WAIT(); asm volatile("" ::: "memory");
    }
}

__device__ __forceinline__ void qk_pack_phase(const Args& a, int gw, int NGW, int lane) {
    unsigned char* ws = a.ws;
    const float* QKV = (const float*)(ws + AT_QKV); bf16* QB = (bf16*)(ws + AT_QB); bf16* KP = (bf16*)(ws + AT_KP); bf16* VP = (bf16*)(ws + AT_VP); bf16* KS = (bf16*)(ws + AT_KS); bf16* VS = (bf16*)(ws + AT_VS);
    const int grp = lane >> 4, j = lane & 15;
    for (int task = gw; task < NTOK + 2 * PAST; task += NGW) {
        if (task >= NTOK) {
            const int i = task - NTOK, b = i / PAST, t = i % PAST;
            const f32x4 k4 = *(const f32x4*)(a.in[I_CK] + (size_t)i * 256 + 4 * lane), v4 = *(const f32x4*)(a.in[I_CV] + (size_t)i * 256 + 4 * lane);
            const size_t o = ((size_t)b * SKV_S + t) * 256 + 4 * lane;
            *(GAS unsigned long long*)(KS + o) = (unsigned long long)pk2(k4.x, k4.y) | ((unsigned long long)pk2(k4.z, k4.w) << 32);
            *(GAS unsigned long long*)(VS + o) = (unsigned long long)pk2(v4.x, v4.y) | ((unsigned long long)pk2(v4.z, v4.w) << 32);
            continue;
        }
        const int row = task; const bool smp = row >= NPTOK; const int bsm = smp ? (row - NPTOK) >> 10 : 0, t = smp ? (row - NPTOK) & (TS - 1) : 0;
        const float pos = (float)((j < 8) ? (t >> 6) : (t & 63));
#pragma unroll
        for (int rd = 0; rd < 3; ++rd) {
            const int hh = rd * 4 + grp;
            const GAS f32x4* src = (const GAS f32x4*)(QKV + (size_t)row * NQKV + hh * 128 + 8 * j);
            const f32x4 lo = src[0], hv = src[1];
            float x[8] = {lo.x, lo.y, lo.z, lo.w, hv.x, hv.y, hv.z, hv.w};
            float ss = 0.f;
#pragma unroll
            for (int e = 0; e < 8; ++e) ss += x[e] * x[e];
            ss += __shfl_xor(ss, 1); ss += __shfl_xor(ss, 2); ss += __shfl_xor(ss, 4); ss += __shfl_xor(ss, 8);
            const float rstd = 1.0f / sqrtf(ss * (1.f / 128.f) + EPS);
            const float* gsrc = (hh < 8) ? a.in[I_QG] : a.in[I_KG];
            float y[8];
#pragma unroll
            for (int e = 0; e < 8; ++e) y[e] = (hh < 10) ? x[e] * rstd * gsrc[8 * j + e] : x[e];
            if (smp) {
                float rr[8];
#pragma unroll
                for (int e = 0; e < 8; ++e) { const float other = __shfl_xor(y[e], 4);
                    const float inv = exp2f(-(float)(8 * (j & 3) + e) * (13.287712379549449f / 32.f)); float sn, cs; sincosf(pos * inv, &sn, &cs);
                    rr[e] = ((j & 4) == 0) ? (y[e] * cs - other * sn) : (other * sn + y[e] * cs); }
                if (hh < 10) {
#pragma unroll
                    for (int e = 0; e < 8; ++e) y[e] = rr[e]; }
            }
            v4u w; w.x = pk2(y[0], y[1]); w.y = pk2(y[2], y[3]); w.z = pk2(y[4], y[5]); w.w = pk2(y[6], y[7]);
            if (hh < 8) { *(GAS v4u*)(QB + (size_t)row * DM + hh * 128 + 8 * j) = w; }
            else { const bool isk = hh < 10; const int kvh = isk ? hh - 8 : hh - 10;
                if (!smp) { float* o = a.out + (isk ? OUT_CK : OUT_CV) + (size_t)row * 256 + kvh * 128 + 8 * j;
                    *(GAS f32x4*)o = (f32x4){y[0], y[1], y[2], y[3]}; *(GAS f32x4*)(o + 4) = (f32x4){y[4], y[5], y[6], y[7]};
                    *(GAS v4u*)((isk ? KP : VP) + (size_t)row * 256 + kvh * 128 + 8 * j) = w; }
                else { *(GAS v4u*)((isk ? KS : VS) + ((size_t)bsm * SKV_S + PAST + t) * 256 + kvh * 128 + 8 * j) = w; } }
        }
    }
}

__device__ __forceinline__ void attn_phase(const Args& a, char* lds) {
    unsigned char* ws = a.ws;
    const att::bf16* QB = (const att::bf16*)(ws + AT_QB); const att::bf16* KP = (const att::bf16*)(ws + AT_KP); const att::bf16* VP = (const att::bf16*)(ws + AT_VP);
    const att::bf16* KS = (const att::bf16*)(ws + AT_KS); const att::bf16* VS = (const att::bf16*)(ws + AT_VS); att::bf16* O = (att::bf16*)(ws + WS_H);
    for (int u = blockIdx.x; u < 192; u += gridDim.x) {
        if (u < 64) { const int b = u >> 5, h = (u & 31) >> 2, qb = u & 3; const size_t q0 = ((size_t)NPTOK + b * TS + qb * 256) * DM + h * 128, k0 = (size_t)b * SKV_S * 256 + (h >> 2) * 128;
            att::attn_dense_body(QB + q0, KS + k0, VS + k0, O + q0, SKV_S, lds); }
        else { const int p = u - 64, b = p >> 3, h = p & 7; const size_t q0 = (size_t)b * TP * DM + h * 128, k0 = (size_t)b * TP * 256 + (h >> 2) * 128;
            att::attn_dense_body(QB + q0, KP + k0, VP + k0, O + q0, TP, lds); }
    }
}

constexpr int N_PHASES = 24;
__global__ void __launch_bounds__(NWAVES * 64, 2) mk_fwd(Args args) {
    extern __shared__ __attribute__((aligned(16))) unsigned char lds[];
    LAS unsigned char* L = (LAS unsigned char*)lds;
    volatile LAS unsigned* MISC = (volatile LAS unsigned*)(L + MISC_OFF);
    const int tid = threadIdx.x, lane = tid & 63, wave = __builtin_amdgcn_readfirstlane(tid >> 6);
    const int G = gridDim.x, gw = blockIdx.x * NWAVES + wave, NGW = G * NWAVES;
    unsigned char* ws = args.ws;
    gu32* ctl = (gu32*)(ws + WS_CTL);
    for (int u = tid; u < (LDS_BYTES - LDSCTL_OFF) / 4; u += NWAVES * 64) ((LAS unsigned*)(L + LDSCTL_OFF))[u] = 0u;
    __syncthreads();
    XcdBarrier bar; bar.bar = (unsigned*)(ctl + CW_BAR); bar.x = 0; bar.st = nullptr;
    if (!MK_PER_PHASE) bar = xcd_barrier_post((unsigned*)(ctl + CW_BAR), MISC + 8);
    const int lo = args.ph_lo, hi = args.ph_hi;
#define IN(k) (lo <= (k) && (k) < hi)
#define SEAM(k) do { if (IN(k) && IN((k) + 1)) xcd_barrier(bar); } while (0)
    bf16* H = (bf16*)(ws + WS_H); bf16* ACT = (bf16*)(ws + WS_ACT); float* P = (float*)(ws + WS_P);
    const bf16* WGU = (const bf16*)(ws + WS_WGU); const bf16* WDN = (const bf16*)(ws + WS_WDN);

#define PH(k, ...) if (IN(k)) { for (int rep_ = 0; rep_ <= (int)((PROBE_MASK >> (k)) & 1u); ++rep_) { if (rep_) xcd_barrier(bar); __VA_ARGS__; } } SEAM(k)
#define FFN_UP(k, m) PH(k, { pg8::Gemm g{H, WGU + (size_t)(m) * NGU * DM, NTOK, NGU, DM, DM, 1}; pg8::StaticOrder S; S.init(NTOK, NGU, 1, G, (int)blockIdx.x); \
        pg8::EpiSwiglu E{ACT, FF}; pg8::gemm_phase<pg8::EpiSwiglu, pg8::StaticOrder, true, true>(L, g, S, E); })
#define FFN_DOWN(k, m) PH(k, { pg8::Gemm g{ACT, WDN + (size_t)(m) * DM * FF, NTOK, DM, FF / 2, FF, 2}; pg8::StaticOrder S; S.init(NTOK, DM, 2, G, (int)blockIdx.x); \
        pg8::EpiF32Slab E{P, (size_t)NTOK * DM, DM}; pg8::gemm_phase<pg8::EpiF32Slab, pg8::StaticOrder, true, true>(L, g, S, E); })
#define PROJ_OUT(k, Wt) PH(k, { pg8::Gemm g{H, (const bf16*)(ws + (Wt)), NTOK, DM, DM / 2, DM, 2}; pg8::StaticOrder S; S.init(NTOK, DM, 2, G, (int)blockIdx.x); \
        pg8::EpiF32Slab E{P, (size_t)NTOK * DM, DM}; pg8::gemm_phase<pg8::EpiF32Slab, pg8::StaticOrder, true, true>(L, g, S, E); })

    PH(0, { p0_mod(args, L, (float*)(ws + WS_MOD), tid, lane, wave); __syncthreads(); p0_weights(args, L, gw, NGW, wave, lane); });
    PH(1, norm_phase<0>(args, gw, NGW, lane, 0, 0, 0.f, 0, 0));
    FFN_UP(2, 0); FFN_DOWN(3, 0);
    PH(4, norm_phase<1>(args, gw, NGW, lane, 0, 0, 0.5f, 0, 1));
    PH(5, { pg8::Gemm g{H, (const bf16*)(ws + WS_WIN), NTOK, 2048, DM, DM, 1}; pg8::StaticOrder S; S.init(NTOK, 2048, 1, G, (int)blockIdx.x);
        pg8::EpiStoreBf16 E{ACT, 2048}; pg8::gemm_phase<pg8::EpiStoreBf16, pg8::StaticOrder, true, true>(L, g, S, E); });
    PH(6, lru_pass<1>(args, L, gw, NGW, wave, lane));
    PH(7, lru_pass<2>(args, L, gw, NGW, wave, lane));
    PROJ_OUT(8, WS_WOUT);
    PH(9, norm_phase<1>(args, gw, NGW, lane, 0, 1, 1.0f, 0, 2));
    FFN_UP(10, 1); FFN_DOWN(11, 1);
    PH(12, norm_phase<1>(args, gw, NGW, lane, 0, 2, 0.5f, 1, 0));
    FFN_UP(13, 2); FFN_DOWN(14, 2);
    PH(15, norm_phase<1>(args, gw, NGW, lane, 1, 0, 0.5f, 1, 1));
    PH(16, { pg8::Gemm g{H, (const bf16*)(ws + WS_WQKV), NTOK, NQKV, DM, DM, 1}; pg8::StaticOrder S; S.init(NTOK, NQKV, 1, G, (int)blockIdx.x);
        pg8::EpiF32Slab E{(float*)(ws + AT_QKV), 0, NQKV}; pg8::gemm_phase<pg8::EpiF32Slab, pg8::StaticOrder, true, true>(L, g, S, E); });
    PH(17, qk_pack_phase(args, gw, NGW, lane));
    PH(18, attn_phase(args, (char*)lds));
    PROJ_OUT(19, WS_WO);
    PH(20, norm_phase<1>(args, gw, NGW, lane, 1, 1, 1.0f, 1, 2));
    FFN_UP(21, 3); FFN_DOWN(22, 3);
    PH(23, norm_phase<2>(args, gw, NGW, lane, 1, 2, 0.5f, 0, 0));
#undef IN
#undef SEAM
}

extern "C" void kernel_launch(void* const* d_in, const int* in_sizes, int n_in, void* d_out, int out_size, void* d_ws, size_t ws_size, hipStream_t stream) {
    static int grid = 0;
    if (grid == 0) {
        if (n_in != N_IN || out_size != (int)OUT_END || ws_size < WS_END) { fprintf(stderr, "kernel_launch: unexpected shapes: n_in %d out %d ws %zu (need %zu)\n", n_in, out_size, ws_size, (size_t)WS_END); grid = -1; return; }
        int dev = 0, cus = 0;
        if (hipGetDevice(&dev) != hipSuccess || hipDeviceGetAttribute(&cus, hipDeviceAttributeMultiprocessorCount, dev) != hipSuccess) { grid = -1; return; }
        if (hipFuncSetAttribute((const void*)mk_fwd, hipFuncAttributeMaxDynamicSharedMemorySize, LDS_BYTES) != hipSuccess) { fprintf(stderr, "kernel_launch: hipFuncSetAttribute failed\n"); grid = -1; return; }
        int per_cu = 0;
        if (hipOccupancyMaxActiveBlocksPerMultiprocessor(&per_cu, (const void*)mk_fwd, NWAVES * 64, LDS_BYTES) != hipSuccess || per_cu < 1) fprintf(stderr, "kernel_launch: occupancy query reports %d\n", per_cu);
        (void)hipGetLastError();
        grid = cus;
    }
    if (grid < 0) return;
    (void)hipMemsetAsync((char*)d_ws + WS_CTL, 0, CTL_ZERO_BYTES, stream);
    Args a{};
    for (int i = 0; i < N_IN; ++i) a.in[i] = (const float*)d_in[i];
    a.out = (float*)d_out; a.ws = (unsigned char*)d_ws;
#if MK_PER_PHASE
    for (int p = 0; p < N_PHASES; ++p) { a.ph_lo = p; a.ph_hi = p + 1; hipLaunchKernelGGL(mk_fwd, dim3(grid), dim3(NWAVES * 64), LDS_BYTES, stream, a); }
#else
    a.ph_lo = 0; a.ph_hi = N_PHASES;
    hipLaunchKernelGGL(mk_fwd, dim3(grid), dim3(NWAVES * 64), LDS_BYTES, stream, a);
#endif
    const hipError_t le = hipPeekAtLastError();
    if (le != hipSuccess) fprintf(stderr, "kernel_launch: launch failed: %s\n", hipGetErrorName(le));
}
```
